# Optimizing an MI355X kernel written in HIP

```python
import math
import jax, jax.numpy as jnp
from jax import lax
import numpy as np

D_MODEL = 2048
BATCH = 1
SEQ = 16384
DEPTH = 2

D_SSM = D_MODEL // 2
SSM_GROUP = 16
N_SSM_GROUPS = D_SSM // SSM_GROUP
SSM_STATE = 64
D_SGU = D_MODEL - D_SSM
SGU_HEADS = 8
SGU_HEAD_DIM = D_SGU // SGU_HEADS
CHUNK = 128
D_FF = 4 * D_MODEL
D_IN = D_SSM + 2 * D_SGU
N_MOD = 6
DEEPNORM_ALPHA = (2.0 * DEPTH) ** 0.25
DEEPNORM_BETA = (8.0 * DEPTH) ** -0.25
LN_EPS = 1e-5
RMS_EPS = 1e-6
DT_MIN = 1e-3
DT_MAX = 1e-1
EIG_RE_MAX = -1e-4

kernel_name = 'hybrid_s5_sgu_deepnorm_adaln'


def layer_norm(x, g, b):
    xf = x.astype(jnp.float32)
    mu = jnp.mean(xf, axis=-1, keepdims=True)
    var = jnp.mean(jnp.square(xf - mu), axis=-1, keepdims=True)
    y = (xf - mu) * lax.rsqrt(var + LN_EPS)
    return (y * g.astype(jnp.float32) + b.astype(jnp.float32)).astype(x.dtype)


def rms_norm(x, g):
    xf = x.astype(jnp.float32)
    y = xf * lax.rsqrt(jnp.mean(jnp.square(xf), axis=-1, keepdims=True) + RMS_EPS)
    return (y * g.astype(jnp.float32)).astype(x.dtype)


def adaln_modulation(c, w, b):
    mod = jax.nn.silu(c) @ w + b
    return jnp.split(mod[:, None, :], N_MOD, axis=-1)


def complex_mul(ar, ai, br, bi):
    return ar * br - ai * bi, ar * bi + ai * br


def s5_scan_combine(e1, e2):
    a1r, a1i, b1r, b1i = e1
    a2r, a2i, b2r, b2i = e2
    ar, ai = complex_mul(a2r, a2i, a1r, a1i)
    br, bi = complex_mul(a2r, a2i, b1r, b1i)
    return ar, ai, br + b2r, bi + b2i


def s5_mixer(u, lam_re, lam_im, log_dt, b_re, b_im, c_re, c_im, d_skip, glu_w, glu_b):
    f32 = jnp.float32
    bsz, L, _ = u.shape
    uf = u.astype(f32).reshape(bsz, L, N_SSM_GROUPS, SSM_GROUP)
    lr = jnp.minimum(lam_re.astype(f32), EIG_RE_MAX)
    li = lam_im.astype(f32)
    dt = jnp.exp(log_dt.astype(f32))[:, None]
    mag = jnp.exp(lr * dt)
    ab_re = mag * jnp.cos(li * dt)
    ab_im = mag * jnp.sin(li * dt)
    den = lr * lr + li * li
    q_re = ((ab_re - 1.0) * lr + ab_im * li) / den
    q_im = (ab_im * lr - (ab_re - 1.0) * li) / den
    bb_re, bb_im = complex_mul(q_re[..., None], q_im[..., None], b_re.astype(f32), b_im.astype(f32))
    bu_re = jnp.einsum('blgh,gph->blgp', uf, bb_re)
    bu_im = jnp.einsum('blgh,gph->blgp', uf, bb_im)
    a_re = jnp.broadcast_to(ab_re, bu_re.shape)
    a_im = jnp.broadcast_to(ab_im, bu_im.shape)
    _, _, h_re, h_im = lax.associative_scan(s5_scan_combine, (a_re, a_im, bu_re, bu_im), axis=1)
    y = (jnp.einsum('blgp,ghp->blgh', h_re, c_re.astype(f32))
         - jnp.einsum('blgp,ghp->blgh', h_im, c_im.astype(f32))
         + d_skip.astype(f32) * uf)
    z = jnp.einsum('blgh,gho->blgo', jax.nn.gelu(y), glu_w.astype(f32)) + glu_b.astype(f32)
    out = z[..., :SSM_GROUP] * jax.nn.sigmoid(z[..., SSM_GROUP:])
    return out.reshape(bsz, L, D_SSM).astype(u.dtype)


def sgu_mixer(u, v, ln_g, ln_b, w_sp, b_sp):
    bsz, L, _ = u.shape
    n_chunks = L // CHUNK
    shp = (bsz, n_chunks, CHUNK, SGU_HEADS, SGU_HEAD_DIM)
    u = jax.nn.gelu(u).reshape(shp)
    v = jax.nn.gelu(v).reshape(shp)
    v = layer_norm(v, ln_g.reshape(SGU_HEADS, SGU_HEAD_DIM), ln_b.reshape(SGU_HEADS, SGU_HEAD_DIM))
    causal = jnp.tril(jnp.ones((CHUNK, CHUNK), dtype=bool))
    w = jnp.where(causal[None], w_sp, jnp.zeros_like(w_sp))
    mixed = jnp.einsum('hts,bnshd->bnthd', w, v) + jnp.swapaxes(b_sp, 0, 1)[:, :, None]
    return (u * mixed).reshape(bsz, L, D_SGU)


def setup_inputs(seed: int = 0) -> dict:
    key = jax.random.key(seed)
    ks = jax.random.split(key, 32)
    f32 = jnp.float32
    G, P, H = N_SSM_GROUPS, SSM_STATE, SSM_GROUP

    def nrm(k, shape, s):
        return s * jax.random.normal(k, shape, f32)

    x = nrm(ks[0], (BATCH, SEQ, D_MODEL), 1.0)
    c = nrm(ks[1], (BATCH, D_MODEL), 1.0)
    ada_w = nrm(ks[2], (DEPTH, D_MODEL, N_MOD * D_MODEL), 0.1 * D_MODEL ** -0.5)
    ada_b = nrm(ks[3], (DEPTH, N_MOD * D_MODEL), 0.02)
    w_in = nrm(ks[4], (DEPTH, D_MODEL, D_IN), D_MODEL ** -0.5)
    ssm_lam_re = -0.5 + nrm(ks[5], (DEPTH, G, P), 0.01)
    ssm_lam_im = math.pi * jnp.arange(P, dtype=f32) + nrm(ks[6], (DEPTH, G, P), 0.01)
    ssm_log_dt = jax.random.uniform(ks[7], (DEPTH, G), f32, math.log(DT_MIN), math.log(DT_MAX))
    ssm_b_re = nrm(ks[8], (DEPTH, G, P, H), (2 * H) ** -0.5)
    ssm_b_im = nrm(ks[9], (DEPTH, G, P, H), (2 * H) ** -0.5)
    ssm_c_re = nrm(ks[10], (DEPTH, G, H, P), (2 * P) ** -0.5)
    ssm_c_im = nrm(ks[11], (DEPTH, G, H, P), (2 * P) ** -0.5)
    ssm_d = nrm(ks[12], (DEPTH, G, H), 1.0)
    glu_w = nrm(ks[13], (DEPTH, G, H, 2 * H), H ** -0.5)
    glu_b = nrm(ks[14], (DEPTH, G, 2 * H), 0.02)
    sgu_ln_g = 1.0 + nrm(ks[15], (DEPTH, D_SGU), 0.02)
    sgu_ln_b = nrm(ks[16], (DEPTH, D_SGU), 0.02)
    sgu_w = nrm(ks[17], (DEPTH, SGU_HEADS, CHUNK, CHUNK), CHUNK ** -0.5)
    sgu_b = 1.0 + nrm(ks[18], (DEPTH, SGU_HEADS, CHUNK), 0.1)
    mix_norm_g = 1.0 + nrm(ks[19], (DEPTH, D_MODEL), 0.02)
    w_out = nrm(ks[20], (DEPTH, D_MODEL, D_MODEL), DEEPNORM_BETA * D_MODEL ** -0.5)
    ln1_g = 1.0 + nrm(ks[21], (DEPTH, D_MODEL), 0.02)
    ln1_b = nrm(ks[22], (DEPTH, D_MODEL), 0.02)
    mlp_w1 = nrm(ks[23], (DEPTH, D_MODEL, D_FF), D_MODEL ** -0.5)
    mlp_w2 = nrm(ks[24], (DEPTH, D_FF, D_MODEL), DEEPNORM_BETA * D_FF ** -0.5)
    ln2_g = 1.0 + nrm(ks[25], (DEPTH, D_MODEL), 0.02)
    ln2_b = nrm(ks[26], (DEPTH, D_MODEL), 0.02)
    return {'x': x, 'c': c, 'ada_w': ada_w, 'ada_b': ada_b, 'w_in': w_in,
            'ssm_lam_re': ssm_lam_re, 'ssm_lam_im': ssm_lam_im, 'ssm_log_dt': ssm_log_dt,
            'ssm_b_re': ssm_b_re, 'ssm_b_im': ssm_b_im, 'ssm_c_re': ssm_c_re, 'ssm_c_im': ssm_c_im,
            'ssm_d': ssm_d, 'glu_w': glu_w, 'glu_b': glu_b,
            'sgu_ln_g': sgu_ln_g, 'sgu_ln_b': sgu_ln_b, 'sgu_w': sgu_w, 'sgu_b': sgu_b,
            'mix_norm_g': mix_norm_g, 'w_out': w_out, 'ln1_g': ln1_g, 'ln1_b': ln1_b,
            'mlp_w1': mlp_w1, 'mlp_w2': mlp_w2, 'ln2_g': ln2_g, 'ln2_b': ln2_b}


def reference(x, c, ada_w, ada_b, w_in, ssm_lam_re, ssm_lam_im, ssm_log_dt, ssm_b_re, ssm_b_im,
              ssm_c_re, ssm_c_im, ssm_d, glu_w, glu_b, sgu_ln_g, sgu_ln_b, sgu_w, sgu_b,
              mix_norm_g, w_out, ln1_g, ln1_b, mlp_w1, mlp_w2, ln2_g, ln2_b):
    for l in range(DEPTH):
        shift1, scale1, gate1, shift2, scale2, gate2 = adaln_modulation(c, ada_w[l], ada_b[l])
        h = x * (1.0 + scale1) + shift1
        proj = h @ w_in[l]
        u_ssm, u_sgu, v_sgu = jnp.split(proj, [D_SSM, D_SSM + D_SGU], axis=-1)
        y_ssm = s5_mixer(u_ssm, ssm_lam_re[l], ssm_lam_im[l], ssm_log_dt[l], ssm_b_re[l], ssm_b_im[l],
                         ssm_c_re[l], ssm_c_im[l], ssm_d[l], glu_w[l], glu_b[l])
        y_sgu = sgu_mixer(u_sgu, v_sgu, sgu_ln_g[l], sgu_ln_b[l], sgu_w[l], sgu_b[l])
        y = jnp.concatenate([rms_norm(y_ssm, mix_norm_g[l, :D_SSM]),
                             rms_norm(y_sgu, mix_norm_g[l, D_SSM:])], axis=-1)
        mix = y @ w_out[l]
        x = layer_norm(DEEPNORM_ALPHA * x + (1.0 + gate1) * mix, ln1_g[l], ln1_b[l])
        h = x * (1.0 + scale2) + shift2
        f = jnp.square(jax.nn.relu(h @ mlp_w1[l])) @ mlp_w2[l]
        x = layer_norm(DEEPNORM_ALPHA * x + (1.0 + gate2) * f, ln2_g[l], ln2_b[l])
    return x
```

```cpp
#include <hip/hip_runtime.h>
#include <hip/hip_cooperative_groups.h>
#include <cstdio>
namespace cg = cooperative_groups;

#define LAS __attribute__((address_space(3)))
#define GAS __attribute__((address_space(1)))
typedef unsigned short bf16_t;
typedef short bf16x8 __attribute__((ext_vector_type(8)));
typedef float f32x4 __attribute__((ext_vector_type(4)));
typedef float f32x2 __attribute__((ext_vector_type(2)));
typedef unsigned u32x4 __attribute__((ext_vector_type(4)));
typedef unsigned u32x2 __attribute__((ext_vector_type(2)));

constexpr int SEQ = 16384, DM = 2048, DIN = 3072, DFF = 8192, DEPTH = 2;
constexpr int NG = 64, NP = 64, NH = 16;
constexpr int SGH = 8;
constexpr float ALPHA = 1.4142135623730951f;
constexpr float LN_EPS = 1e-5f, RMS_EPS = 1e-6f;
constexpr int NTHREADS = 512, NWAVES = 8;
constexpr int LDS_BYTES = 147456;
constexpr int SEGLEN = 512, NSEG = SEQ / SEGLEN;

constexpr size_t MiB = 1u << 20;
constexpr size_t WS_WIN = 0;
constexpr size_t WS_WOUT = 24 * MiB;
constexpr size_t WS_W1 = 40 * MiB;
constexpr size_t WS_W2 = 104 * MiB;
constexpr size_t WS_H = 168 * MiB;
constexpr size_t WS_BIG = 232 * MiB;
constexpr size_t WS_PROJ = WS_BIG;
constexpr size_t WS_Y = WS_BIG + 96 * MiB;
constexpr size_t WS_SMALL = 488 * MiB;
constexpr size_t WS_MODPART = WS_SMALL;
constexpr size_t WS_MOD = WS_SMALL + 2 * MiB;
constexpr size_t WS_AB = WS_SMALL + 3 * MiB;
constexpr size_t WS_ABS = WS_AB + 65536;
constexpr size_t WS_BBF = WS_SMALL + 4 * MiB;
constexpr size_t WS_CF = WS_BBF + 512 * 1024;
constexpr size_t WS_SGUW = WS_SMALL + 5 * MiB;
constexpr size_t WS_E = WS_SMALL + 6 * MiB;
constexpr size_t WS_RS = WS_SMALL + 7 * MiB;
constexpr size_t WS_BAR = WS_SMALL + 7 * MiB + 512 * 1024;
constexpr size_t WS_ZX = WS_SMALL + 8 * MiB;
constexpr size_t WS_RSP = WS_ZX + 64 * MiB;
constexpr size_t WS_RS2 = WS_RSP + 6 * MiB;
constexpr size_t WS_END = WS_RSP + 8 * MiB;

typedef __bf16 bf16x2_t __attribute__((ext_vector_type(2)));
__device__ __forceinline__ unsigned cvt_pk_bf16(float lo, float hi) { const f32x2 v = {lo, hi}; const bf16x2_t b = __builtin_convertvector(v, bf16x2_t); return __builtin_bit_cast(unsigned, b); }
__device__ __forceinline__ bf16_t f2bf(float f) { unsigned u = __builtin_bit_cast(unsigned, f); return (bf16_t)((u + 0x7fffu + ((u >> 16) & 1u)) >> 16); }
__device__ __forceinline__ float bf2f(unsigned short b) { return __builtin_bit_cast(float, ((unsigned)b) << 16); }
__device__ __forceinline__ float gelu_tanh(float x) {
    const float u = x * (1.0f + 0.044715f * x * x);
    const float e = __builtin_amdgcn_exp2f(-2.3022082f * u);
    return x * __builtin_amdgcn_rcpf(1.0f + e);
}
__device__ __forceinline__ float sigmoidf_(float x) { return __builtin_amdgcn_rcpf(1.0f + __builtin_amdgcn_exp2f(-1.44269504f * x)); }
__device__ __forceinline__ float wave_sum(float v) {
#pragma unroll
    for (int o = 1; o < 64; o <<= 1) v += __shfl_xor(v, o);
    return v;
}
#if defined(__HIP_DEVICE_COMPILE__)
#define ASSUME_GLOBAL(p) do { __builtin_assume(!__builtin_amdgcn_is_shared((const void*)(p))); __builtin_assume(!__builtin_amdgcn_is_private((const void*)(p))); } while (0)
#else
#define ASSUME_GLOBAL(p) do { } while (0)
#endif
constexpr float FX_RS = 16777216.0f, FX_RS_INV = 1.0f / 16777216.0f;
__device__ __forceinline__ void fx_add(long long* p, float v, float scale) { __hip_atomic_fetch_add((GAS long long*)p, (long long)__float2ll_rn(v * scale), __ATOMIC_RELAXED, __HIP_MEMORY_SCOPE_AGENT); }
__device__ __forceinline__ float fx_get(const long long* p, float inv) { return (float)(*(const GAS long long*)p) * inv; }
#define LDS_WAIT() asm volatile("s_waitcnt lgkmcnt(0)" ::: "memory")

#define XB_TMO      128
#define XB_XCNT(j)  (256  + 64 * (j))
#define XB_XSUB(j)  (1280 + 64 * (j))
#define XB_XGEN(j)  (2304 + 64 * (j))
#define XB_TOP      3328
#define XB_TOPGEN   3392
#define XCD_BAR_WORDS 3456
#define XB_SPIN_CAP (1u << 20)
__device__ __forceinline__ unsigned xb_ld(unsigned* p)              { return __hip_atomic_load(p, __ATOMIC_RELAXED, __HIP_MEMORY_SCOPE_AGENT); }
__device__ __forceinline__ unsigned xb_add(unsigned* p, unsigned v) { return __hip_atomic_fetch_add(p, v, __ATOMIC_RELAXED, __HIP_MEMORY_SCOPE_AGENT); }
__device__ __forceinline__ unsigned xb_xcc_id() { return (unsigned)__builtin_amdgcn_s_getreg((3 << 11) | 20) & 0xFu; }
#define XB_SPIN(cond, bar) do { unsigned _sp = 0; while (cond) { __builtin_amdgcn_s_sleep(1); \
    if ((++_sp & 255u) == 0u) { if (xb_ld(&(bar)[XB_TMO])) break; if (_sp > XB_SPIN_CAP) { atomicAdd(&(bar)[XB_TMO], 1u); break; } } } } while (0)
struct XcdBarrier { unsigned* bar; unsigned x; volatile LAS unsigned* st; };
__device__ __forceinline__ XcdBarrier xcd_barrier_post(unsigned* bar, volatile LAS unsigned* st) {
    XcdBarrier b; b.bar = bar; b.x = xb_xcc_id(); b.st = st;
    if (threadIdx.x == 0) (void)xb_add(&bar[XB_XCNT(b.x)], 1u);
    return b;
}
__device__ __forceinline__ void xcd_barrier_complete(unsigned* bar, unsigned x, unsigned& nloc, unsigned& nx) {
    const unsigned G = gridDim.x * gridDim.y * gridDim.z;
    unsigned sum, cnt, mine, sp = 0u;
    for (;;) {
        sum = 0u; cnt = 0u; mine = 0u;
#pragma unroll
        for (unsigned j = 0; j < 16; ++j) { const unsigned c = xb_ld(&bar[XB_XCNT(j)]); sum += c; cnt += (c > 0u) ? 1u : 0u; mine = (j == x) ? c : mine; }
        if (sum == G) break;
        __builtin_amdgcn_s_sleep(1);
        if ((++sp & 255u) == 0u) { if (xb_ld(&bar[XB_TMO])) break; if (sp > XB_SPIN_CAP) { atomicAdd(&bar[XB_TMO], 1u); break; } }
    }
    nloc = mine > 0u ? mine : 1u; nx = cnt > 0u ? cnt : 1u;
}
__device__ __forceinline__ void xcd_barrier(const XcdBarrier& b) {
    asm volatile("s_waitcnt vmcnt(0) lgkmcnt(0)" ::: "memory");
    __syncthreads();
    if (threadIdx.x == 0) {
        unsigned* bar = b.bar;
        __builtin_amdgcn_s_waitcnt(0);
        unsigned nloc = b.st[0], nx = b.st[1];
        if (nloc == 0u) { xcd_barrier_complete(bar, b.x, nloc, nx); b.st[0] = nloc; b.st[1] = nx; }
        const unsigned old = xb_add(&bar[XB_XSUB(b.x)], 1u);
        const unsigned gen = old / nloc;
        if (old + 1u == (gen + 1u) * nloc) {
            __builtin_amdgcn_fence(__ATOMIC_RELEASE, "agent");
            asm volatile("s_waitcnt vmcnt(0)" ::: "memory");
            const unsigned og = xb_add(&bar[XB_TOP], 1u);
            const unsigned tg = og / nx;
            if (og + 1u == (tg + 1u) * nx) xb_add(&bar[XB_TOPGEN], 1u);
            else XB_SPIN(xb_ld(&bar[XB_TOPGEN]) == tg, bar);
            __builtin_amdgcn_fence(__ATOMIC_ACQUIRE, "agent");
            xb_add(&bar[XB_XGEN(b.x)], 1u);
            asm volatile("s_waitcnt vmcnt(0)" ::: "memory");
        } else {
            XB_SPIN(xb_ld(&bar[XB_XGEN(b.x)]) == gen, bar);
            __builtin_amdgcn_fence(__ATOMIC_ACQUIRE, "agent");
            asm volatile("s_waitcnt vmcnt(0)" ::: "memory");
        }
    }
    __syncthreads();
}

namespace pg8 {
constexpr int BM = 256, BK = 64, HALF = 128, HTB = HALF * BK * 2, STAGE_BYTES = 8 * HTB, NXCD = 8, WGM = 4;
__host__ __device__ __forceinline__ int lds_byte(int r, int c) { const int st = (r >> 4) * 2 + (c >> 5), rr = r & 15, cc = c & 31, ob = rr * 64 + cc * 2; return st * 1024 + (ob ^ (((ob >> 9) & 1) << 5)); }
__host__ __device__ __forceinline__ void stage_rc(int b, int& R, int& C) { const int st = b / 1024, sb = b % 1024, swz = sb ^ (((sb >> 9) & 1) << 5); R = (st >> 1) * 16 + swz / 64; C = (st & 1) * 32 + (swz % 64) / 2; }
__host__ __device__ __forceinline__ int perm32(int rho) { const int n = rho >> 4, i = rho & 15; return 8 * (i >> 2) + 4 * n + (i & 3); }
struct Unit { int pm, pn; };
struct Gemm { const bf16_t* A; const bf16_t* Bt; int M, N, K; };
struct StaticOrder {
    int nM, nN, nwg, G, c, rev;
    __device__ void init(int M, int N, int G_, int c_, int rev_ = 0) { nM = M / BM; nN = N / BM; nwg = nM * nN; G = G_; c = c_; rev = rev_; }
    __device__ bool next(int i, Unit& u) const {
        const long L = (long)i * G + c; if (L >= nwg) return false;
        int wgid = (int)L; { const int q = nwg / NXCD, r = nwg % NXCD, xcd = wgid % NXCD, off = wgid / NXCD; wgid = (xcd < r ? xcd * (q + 1) : r * (q + 1) + (xcd - r) * q) + off; }
        const int nig = WGM * nN, gid = wgid / nig, fm = gid * WGM, gsz = (nM - fm) < WGM ? (nM - fm) : WGM;
        u.pm = fm + ((wgid % nig) % gsz); u.pn = (wgid % nig) / gsz; if (rev) u.pm = nM - 1 - u.pm; return true;
    }
    __device__ __forceinline__ void a_ready(const Unit&) const {}
    __device__ __forceinline__ void done(const Unit&) const {}
};

template <class Epi, class Sched>
__device__ __forceinline__ void gemm_phase(LAS unsigned char* lds, const Gemm g, const Sched& S, const Epi& E, const int tid) {
    const int wid = __builtin_amdgcn_readfirstlane(tid >> 6), lane = tid & 63, wr = wid >> 2, wc = wid & 3, fr = lane & 15, fq = lane >> 4;
    const int K = g.K, nt = K / BK;
    unsigned voffA[2], voffB[2];
#pragma unroll
    for (int i = 0; i < 2; ++i) { int R, C; stage_rc(tid * 16 + i * 8192, R, C); const int Rb = (R & ~31) + perm32(R & 31);
        voffA[i] = (unsigned)(R * K + C) * 2u; voffB[i] = (unsigned)(Rb * K + C) * 2u; }
    const size_t kstep = (size_t)(BK * 2);
    const size_t hstep = (size_t)HALF * K * 2;
    const size_t tstep = 2 * hstep;
    const unsigned ldsw = (unsigned)wid * 1024u;
    const int aoff = lds_byte(wr * 64 + fr, fq * 8), boff = lds_byte(wc * 32 + fr, fq * 8);
#define PG8_SA(b, h) (((b) * 2 + (h)) * HTB)
#define PG8_SB(b, h) ((4 + (b) * 2 + (h)) * HTB)
#define PG8_STAGE(bufoff, gbase, voff) do { _Pragma("unroll") for (int _i = 0; _i < 2; ++_i) \
        __builtin_amdgcn_global_load_lds((const unsigned*)((const char*)(gbase) + (voff)[_i]), (LAS unsigned*)(lds + (bufoff) + ldsw + _i * 8192), 16, 0, 0); } while (0)
#define PG8_LDA(dst, b, h) do { _Pragma("unroll") for (int m = 0; m < 4; ++m) _Pragma("unroll") for (int k = 0; k < 2; ++k) dst[m][k] = *(const LAS bf16x8*)(lds + PG8_SA(b, h) + aoff + m * 2048 + k * 1024); } while (0)
#define PG8_LDB(dst, b, h) do { _Pragma("unroll") for (int n = 0; n < 2; ++n) _Pragma("unroll") for (int k = 0; k < 2; ++k) dst[n][k] = *(const LAS bf16x8*)(lds + PG8_SB(b, h) + boff + n * 2048 + k * 1024); } while (0)
#define PG8_MMA(ai, bj, At, Bt) do { __builtin_amdgcn_s_setprio(1); _Pragma("unroll") for (int m = 0; m < 4; ++m) _Pragma("unroll") for (int n = 0; n < 2; ++n) _Pragma("unroll") for (int k = 0; k < 2; ++k) \
        acc[ai][bj][m][n] = __builtin_amdgcn_mfma_f32_16x16x32_bf16(Bt[n][k], At[m][k], acc[ai][bj][m][n], 0, 0, 0); __builtin_amdgcn_s_setprio(0); } while (0)
#define PG8_WAIT_V(n) asm volatile("s_waitcnt vmcnt(" #n ")" ::: "memory")
#define PG8_WAIT_L(n) asm volatile("s_waitcnt lgkmcnt(" #n ")" ::: "memory")
#define PG8_BAR __builtin_amdgcn_s_barrier()
#define PG8_SCHED __builtin_amdgcn_sched_barrier(0)
    Unit cur, nxt; int ui = 0;
    if (!S.next(0, cur)) return;
    f32x4 acc[2][2][4][2];
#pragma unroll
    for (int a = 0; a < 2; ++a)
#pragma unroll
        for (int b = 0; b < 2; ++b)
#pragma unroll
            for (int m = 0; m < 4; ++m)
#pragma unroll
                for (int n = 0; n < 2; ++n) acc[a][b][m][n] = (f32x4){0.f, 0.f, 0.f, 0.f};
    bf16x8 At[4][2], B0[2][2], B1[2][2];
    const char* cA = (const char*)g.A + (size_t)cur.pm * tstep; const char* cB = (const char*)g.Bt + (size_t)cur.pn * tstep;
    S.a_ready(cur);
    PG8_STAGE(PG8_SB(0, 0), cB, voffB); PG8_STAGE(PG8_SA(0, 0), cA, voffA); PG8_STAGE(PG8_SB(0, 1), cB + hstep, voffB); PG8_STAGE(PG8_SA(0, 1), cA + hstep, voffA);
    if (wr == 1) PG8_BAR;
    PG8_WAIT_V(4); PG8_BAR;
    PG8_STAGE(PG8_SB(1, 0), cB + kstep, voffB); PG8_STAGE(PG8_SA(1, 0), cA + kstep, voffA); PG8_STAGE(PG8_SB(1, 1), cB + hstep + kstep, voffB);
    PG8_WAIT_V(6); PG8_BAR;
    for (;;) {
        const bool has_next = S.next(ui + 1, nxt);
        const char* nA = has_next ? (const char*)g.A + (size_t)nxt.pm * tstep : cA; const char* nB = has_next ? (const char*)g.Bt + (size_t)nxt.pn * tstep : cB;
        for (int t = 0; t < nt; t += 2) {
            const bool last = (t == nt - 2);
            const char* a1 = cA + (size_t)(t + 1) * kstep;
            const char* a2 = last ? nA : cA + (size_t)(t + 2) * kstep; const char* b2 = last ? nB : cB + (size_t)(t + 2) * kstep;
            const char* a3 = a2 + kstep; const char* b3 = b2 + kstep;
            if (last && has_next) S.a_ready(nxt);
            if (E.rs2 && t == nt / 2) { PG8_SCHED; E.mid(acc, cur, wr, fr); PG8_SCHED; }
            PG8_LDB(B0, 0, 0); PG8_SCHED; PG8_LDA(At, 0, 0); PG8_STAGE(PG8_SA(1, 1), a1 + hstep, voffA);
            PG8_WAIT_L(8); PG8_BAR; PG8_WAIT_L(0); PG8_MMA(0, 0, At, B0); PG8_BAR; PG8_SCHED;
            PG8_LDB(B1, 0, 1); PG8_STAGE(PG8_SB(0, 0), b2, voffB);
            PG8_BAR; PG8_WAIT_L(0); PG8_MMA(0, 1, At, B1); PG8_BAR;
            PG8_LDA(At, 0, 1); PG8_STAGE(PG8_SA(0, 0), a2, voffA);
            PG8_BAR; PG8_WAIT_L(0); PG8_MMA(1, 0, At, B0); PG8_BAR; PG8_SCHED;
            PG8_STAGE(PG8_SB(0, 1), b2 + hstep, voffB);
            PG8_WAIT_V(6); PG8_BAR; PG8_MMA(1, 1, At, B1); PG8_BAR;
            PG8_LDB(B0, 1, 0); PG8_SCHED; PG8_LDA(At, 1, 0); PG8_STAGE(PG8_SA(0, 1), a2 + hstep, voffA);
            PG8_WAIT_L(8); PG8_BAR; PG8_WAIT_L(0); PG8_MMA(0, 0, At, B0); PG8_BAR; PG8_SCHED;
            PG8_LDB(B1, 1, 1); PG8_STAGE(PG8_SB(1, 0), b3, voffB);
            PG8_BAR; PG8_WAIT_L(0); PG8_MMA(0, 1, At, B1); PG8_BAR;
            PG8_LDA(At, 1, 1); PG8_STAGE(PG8_SA(1, 0), a3, voffA);
            PG8_BAR; PG8_WAIT_L(0); PG8_MMA(1, 0, At, B0); PG8_BAR; PG8_SCHED;
            PG8_STAGE(PG8_SB(1, 1), b3 + hstep, voffB);
            PG8_WAIT_V(6); PG8_BAR; PG8_MMA(1, 1, At, B1); PG8_BAR;
        }
        E(acc, cur, wr, wc, fr, fq); S.done(cur);
        if (!has_next) break;
#pragma unroll
        for (int a = 0; a < 2; ++a)
#pragma unroll
            for (int b = 0; b < 2; ++b)
#pragma unroll
                for (int m = 0; m < 4; ++m)
#pragma unroll
                    for (int n = 0; n < 2; ++n) acc[a][b][m][n] = (f32x4){0.f, 0.f, 0.f, 0.f};
        cur = nxt; cA = nA; cB = nB; ++ui;
    }
    PG8_WAIT_V(0);
    if (wr == 0) PG8_BAR;
    PG8_BAR;
#undef PG8_SA
#undef PG8_SB
#undef PG8_STAGE
#undef PG8_LDA
#undef PG8_LDB
#undef PG8_MMA
#undef PG8_WAIT_V
#undef PG8_WAIT_L
#undef PG8_BAR
#undef PG8_SCHED
}
}

struct EpiAll {
    int mode;
    bf16_t* O; int ldc;
    const float* xin; const float* gate;
    const long long* rs2;
    __device__ __forceinline__ void mid(f32x4 (&acc)[2][2][4][2], const pg8::Unit& u, int wr, int fr) const {
        const int row0 = u.pm * 256 + wr * 64 + fr;
#pragma unroll
        for (int ai = 0; ai < 2; ++ai)
#pragma unroll
            for (int m = 0; m < 4; ++m) { int r = row0 + ai * 128 + m * 16; asm volatile("" : "+v"(r));
                const float a = fx_get(rs2 + r, FX_RS_INV) * (1.0f / 1024.0f) + RMS_EPS, b = fx_get(rs2 + SEQ + r, FX_RS_INV) * (1.0f / 1024.0f) + RMS_EPS;
                const float ratio = __builtin_amdgcn_sqrtf(b * __builtin_amdgcn_rcpf(a));
#pragma unroll
                for (int bj = 0; bj < 2; ++bj)
#pragma unroll
                    for (int n = 0; n < 2; ++n) acc[ai][bj][m][n] *= ratio; }
    }
    template <int ACT> __device__ __forceinline__ void store_bf16(const f32x4 (&acc)[2][2][4][2], const pg8::Unit& u, int wr, int wc, int fr, int fq) const {
        const int row0 = u.pm * 256 + wr * 64 + fr, col0 = u.pn * 256 + wc * 32 + 8 * fq;
#pragma unroll
        for (int ai = 0; ai < 2; ++ai)
#pragma unroll
            for (int m = 0; m < 4; ++m) { bf16_t* rowp = O + (size_t)(row0 + ai * 128 + m * 16) * ldc + col0;
#pragma unroll
                for (int bj = 0; bj < 2; ++bj) { f32x4 v0 = acc[ai][bj][m][0], v1 = acc[ai][bj][m][1];
                    if (ACT == 1) {
#pragma unroll
                        for (int j = 0; j < 4; ++j) { v0[j] = gelu_tanh(v0[j]); v1[j] = gelu_tanh(v1[j]); } }
                    if (ACT == 2) {
#pragma unroll
                        for (int j = 0; j < 4; ++j) { const float a = fmaxf(v0[j], 0.f), b = fmaxf(v1[j], 0.f); v0[j] = a * a; v1[j] = b * b; } }
                    u32x4 w; w.x = cvt_pk_bf16(v0[0], v0[1]); w.y = cvt_pk_bf16(v0[2], v0[3]); w.z = cvt_pk_bf16(v1[0], v1[1]); w.w = cvt_pk_bf16(v1[2], v1[3]);
                    *(GAS u32x4*)(rowp + bj * 128) = w; } }
    }
    template <bool XF32> __device__ __forceinline__ void store_res(const f32x4 (&acc)[2][2][4][2], const pg8::Unit& u, int wr, int wc, int fr, int fq) const {
        const int row0 = u.pm * 256 + wr * 64 + fr, col0 = u.pn * 256 + wc * 32 + 8 * fq;
        f32x4 gv[2][2];
#pragma unroll
        for (int bj = 0; bj < 2; ++bj)
#pragma unroll
            for (int n = 0; n < 2; ++n) gv[bj][n] = *(const GAS f32x4*)(gate + col0 + bj * 128 + n * 4) + 1.0f;
#pragma unroll
        for (int ai = 0; ai < 2; ++ai) {
            float rsc[4];
#pragma unroll
            for (int m = 0; m < 4; ++m) rsc[m] = rs2 ? __builtin_amdgcn_rsqf(fx_get(rs2 + SEQ + row0 + ai * 128 + m * 16, FX_RS_INV) * (1.0f / 1024.0f) + RMS_EPS) : 1.0f;
            u32x4 xpre[4][2];
            if (!XF32) {
#pragma unroll
                for (int m = 0; m < 4; ++m)
#pragma unroll
                    for (int bj = 0; bj < 2; ++bj) xpre[m][bj] = *(const GAS u32x4*)(O + (size_t)(row0 + ai * 128 + m * 16) * DM + col0 + bj * 128); }
#pragma unroll
            for (int m = 0; m < 4; ++m) { const size_t off = (size_t)(row0 + ai * 128 + m * 16) * DM + col0;
#pragma unroll
                for (int bj = 0; bj < 2; ++bj) { f32x4 x0, x1;
                    if (XF32) { x0 = *(const GAS f32x4*)(xin + off + bj * 128); x1 = *(const GAS f32x4*)(xin + off + bj * 128 + 4); }
                    else { const u32x4 xb = xpre[m][bj];
                        x0 = (f32x4){bf2f((unsigned short)(xb.x & 0xffff)), bf2f((unsigned short)(xb.x >> 16)), bf2f((unsigned short)(xb.y & 0xffff)), bf2f((unsigned short)(xb.y >> 16))};
                        x1 = (f32x4){bf2f((unsigned short)(xb.z & 0xffff)), bf2f((unsigned short)(xb.z >> 16)), bf2f((unsigned short)(xb.w & 0xffff)), bf2f((unsigned short)(xb.w >> 16))}; }
                    const f32x4 z0 = ALPHA * x0 + gv[bj][0] * (acc[ai][bj][m][0] * rsc[m]), z1 = ALPHA * x1 + gv[bj][1] * (acc[ai][bj][m][1] * rsc[m]);
                    u32x4 w; w.x = cvt_pk_bf16(z0[0], z0[1]); w.y = cvt_pk_bf16(z0[2], z0[3]); w.z = cvt_pk_bf16(z1[0], z1[1]); w.w = cvt_pk_bf16(z1[2], z1[3]);
                    *(GAS u32x4*)(O + off + bj * 128) = w; }
                if (XF32) asm volatile("" ::: "memory"); } }
    }
    __device__ __forceinline__ void operator()(const f32x4 (&acc)[2][2][4][2], const pg8::Unit& u, int wr, int wc, int fr, int fq) const {
        if (mode == 0) { if (u.pn >= 4) store_bf16<1>(acc, u, wr, wc, fr, fq); else store_bf16<0>(acc, u, wr, wc, fr, fq); }
        else if (mode == 2) store_bf16<2>(acc, u, wr, wc, fr, fq);
        else if (xin) store_res<true>(acc, u, wr, wc, fr, fq);
        else store_res<false>(acc, u, wr, wc, fr, fq);
    }
};

struct Params { const float* in[27]; float* out; unsigned char* ws; };
enum { I_X = 0, I_C, I_ADAW, I_ADAB, I_WIN, I_LRE, I_LIM, I_LDT, I_BRE, I_BIM, I_CRE, I_CIM, I_SD, I_GLUW, I_GLUB, I_SLNG, I_SLNB, I_SGW, I_SGB, I_MNG, I_WOUT, I_LN1G, I_LN1B, I_W1, I_W2, I_LN2G, I_LN2B };

constexpr int MISC_OFF = LDS_BYTES - 1024;
constexpr int PTR_OFF = LDS_BYTES - 512;
constexpr int S5_STRIDE = 17408;
__device__ __forceinline__ const float* inptr(LAS unsigned char* lds, int i) {
    volatile LAS unsigned* q = (volatile LAS unsigned*)(lds + PTR_OFF + 8 * i);
    const unsigned lo = __builtin_amdgcn_readfirstlane(q[0]), hi = __builtin_amdgcn_readfirstlane(q[1]);
    const float* r = (const float*)(((unsigned long long)hi << 32) | lo); ASSUME_GLOBAL(r); return r;
}
struct PtrTab { LAS unsigned char* lds; __device__ __forceinline__ const float* operator[](int i) const { return inptr(lds, i); } };
struct PView { PtrTab in; float* out; unsigned char* ws; };

struct TrItem { const float* W; bf16_t* WT; const float* kscale; int K, N, item; };
__device__ __forceinline__ void tr_load(const TrItem& t, f32x4 (&v)[8], int lane) {
    const int nblk = t.N / 32, kb = t.item / nblk, nb = t.item % nblk, k0 = 64 * kb, n0 = 32 * nb;
#pragma unroll
    for (int i = 0; i < 8; ++i) v[i] = __builtin_nontemporal_load((const GAS f32x4*)(t.W + (size_t)(k0 + 8 * i + (lane >> 3)) * t.N + n0 + 4 * (lane & 7)));
}
__device__ __forceinline__ void tr_finish(const TrItem& t, const f32x4 (&v)[8], LAS float* scr, int lane) {
    const int nblk = t.N / 32, kb = t.item / nblk, nb = t.item % nblk, k0 = 64 * kb, n0 = 32 * nb;
#pragma unroll
    for (int i = 0; i < 8; ++i) { const int kk = 8 * i + (lane >> 3); f32x4 x = v[i]; if (t.kscale) x *= t.kscale[k0 + kk];
        LAS float* d = scr + kk * 33 + 4 * (lane & 7); d[0] = x[0]; d[1] = x[1]; d[2] = x[2]; d[3] = x[3]; }
    LDS_WAIT();
    const int c = lane & 7;
#pragma unroll
    for (int j = 0; j < 4; ++j) { const int n = (lane >> 3) + 8 * j; const LAS float* sp = scr + (8 * c) * 33 + n;
        u32x4 o; o.x = cvt_pk_bf16(sp[0 * 33], sp[1 * 33]); o.y = cvt_pk_bf16(sp[2 * 33], sp[3 * 33]); o.z = cvt_pk_bf16(sp[4 * 33], sp[5 * 33]); o.w = cvt_pk_bf16(sp[6 * 33], sp[7 * 33]);
        __builtin_nontemporal_store(o, (GAS u32x4*)(t.WT + (size_t)(n0 + n) * t.K + k0 + 8 * c)); }
    LDS_WAIT();
}
struct TrPair { const float* W0; bf16_t* T0; const float* s0; int K0, N0, n0; const float* W1; bf16_t* T1; const float* s1; int K1, N1, n1; };
__device__ __forceinline__ TrItem tr_make(const TrPair& p, int it) { TrItem t;
    if (it < p.n0) { t.W = p.W0; t.WT = p.T0; t.kscale = p.s0; t.K = p.K0; t.N = p.N0; t.item = it; }
    else { t.W = p.W1; t.WT = p.T1; t.kscale = p.s1; t.K = p.K1; t.N = p.N1; t.item = it - p.n0; }
    return t; }
__device__ __forceinline__ void tr_run(const TrPair& p, LAS float* scr, int first, int stride, int lane) {
    const int total = p.n0 + p.n1;
    f32x4 vn[8]; TrItem tn;
    if (first < total) { tn = tr_make(p, first); tr_load(tn, vn, lane); }
    for (int it = first; it < total; it += stride) { const TrItem tc = tn; f32x4 vc[8];
#pragma unroll
        for (int i = 0; i < 8; ++i) vc[i] = vn[i];
        if (it + stride < total) { tn = tr_make(p, it + stride); tr_load(tn, vn, lane); }
        tr_finish(tc, vc, scr, lane); }
}
__device__ __forceinline__ void sincos_red(double ang, double& s, double& c) {
    const double TWO_PI = 6.283185307179586476925286766559;
    const double r = ang - TWO_PI * __builtin_rint(ang / TWO_PI);
    const double r2 = r * r; double ts = r, tc = 1.0; s = r; c = 1.0;
#pragma unroll 1
    for (int k = 1; k <= 16; ++k) { tc = -tc * r2 / (double)((2 * k - 1) * (2 * k)); ts = -ts * r2 / (double)((2 * k) * (2 * k + 1)); c += tc; s += ts; }
}
__device__ __forceinline__ double exp_small(double x) {
    double t = 1.0, s = 1.0;
#pragma unroll 1
    for (int k = 1; k <= 14; ++k) { t = t * x / (double)k; s += t; }
    return s;
}

__device__ __forceinline__ void phase_prologue(const PView& p, LAS unsigned char* lds, int tid, int lane, int wave) {
    const float* const in_I_ADAW = p.in[I_ADAW]; const float* const in_I_BIM = p.in[I_BIM]; const float* const in_I_BRE = p.in[I_BRE]; const float* const in_I_C = p.in[I_C]; const float* const in_I_CIM = p.in[I_CIM]; const float* const in_I_CRE = p.in[I_CRE]; const float* const in_I_LDT = p.in[I_LDT]; const float* const in_I_LIM = p.in[I_LIM]; const float* const in_I_LRE = p.in[I_LRE]; const float* const in_I_MNG = p.in[I_MNG]; const float* const in_I_SGW = p.in[I_SGW]; const float* const in_I_W1 = p.in[I_W1]; const float* const in_I_W2 = p.in[I_W2]; const float* const in_I_WIN = p.in[I_WIN]; const float* const in_I_WOUT = p.in[I_WOUT];
    unsigned char* ws = p.ws;
    const int G = gridDim.x, gw = blockIdx.x * NWAVES + wave, NGW = G * NWAVES, gtid = blockIdx.x * NTHREADS + tid, NGT = G * NTHREADS;
    { long long* r2 = (long long*)(ws + WS_RS2); for (int i = gtid; i < DEPTH * 2 * SEQ; i += NGT) r2[i] = 0; }
    { const float* c = in_I_C; const float* aw = in_I_ADAW; float* part = (float*)(ws + WS_MODPART);
      for (int it = gw; it < 2 * 48 * 16; it += NGW) { const int l = it / 768, r = it % 768, nb = r / 16, ks = r % 16;
          const float c0 = c[ks * 128 + lane], c1 = c[ks * 128 + 64 + lane];
          const float s0 = c0 * sigmoidf_(c0), s1 = c1 * sigmoidf_(c1);
          const float* wp = aw + ((size_t)l * DM + ks * 128) * (6 * DM) + nb * 256 + lane * 4;
          f32x4 a = (f32x4){0.f, 0.f, 0.f, 0.f};
#pragma unroll 8
          for (int kk = 0; kk < 64; ++kk) { const float s = __builtin_bit_cast(float, __builtin_amdgcn_readlane(__builtin_bit_cast(int, s0), kk)); a += s * *(const GAS f32x4*)(wp + (size_t)kk * (6 * DM)); }
#pragma unroll 8
          for (int kk = 0; kk < 64; ++kk) { const float s = __builtin_bit_cast(float, __builtin_amdgcn_readlane(__builtin_bit_cast(int, s1), kk)); a += s * *(const GAS f32x4*)(wp + (size_t)(64 + kk) * (6 * DM)); }
          *(GAS f32x4*)(part + ((size_t)ks * 2 + l) * (6 * DM) + nb * 256 + lane * 4) = a; } }
    for (int idx = gtid; idx < DEPTH * NG * NP; idx += NGT) { const int lg = idx / NP, pp = idx % NP;
        const double lr = fmin((double)in_I_LRE[idx], -1e-4), li = (double)in_I_LIM[idx];
        const double dt = (double)__builtin_amdgcn_exp2f(in_I_LDT[lg] * 1.44269504f);
        const double mag = exp_small(lr * dt); double sn, cs; sincos_red(li * dt, sn, cs);
        const double are = mag * cs, aim = mag * sn;
        ((f32x2*)(ws + WS_AB))[idx] = (f32x2){(float)are, (float)aim};
        double ms = mag;
#pragma unroll 1
        for (int k = 0; k < 9; ++k) ms = ms * ms;
        double sn2, cs2; sincos_red(li * dt * (double)SEGLEN, sn2, cs2);
        ((f32x2*)(ws + WS_ABS))[idx] = (f32x2){(float)(ms * cs2), (float)(ms * sn2)};
        const double den = lr * lr + li * li, qre = ((are - 1.0) * lr + aim * li) / den, qim = (aim * lr - (are - 1.0) * li) / den;
        bf16_t* bb = (bf16_t*)(ws + WS_BBF) + ((size_t)lg * 128 + 2 * pp) * 16;
#pragma unroll 1
        for (int h = 0; h < NH; ++h) { const double br = (double)in_I_BRE[(size_t)idx * NH + h], bi = (double)in_I_BIM[(size_t)idx * NH + h];
            bb[h] = f2bf((float)(qre * br - qim * bi)); bb[16 + h] = f2bf((float)(qre * bi + qim * br)); } }
    { bf16_t* cf = (bf16_t*)(ws + WS_CF);
      for (int i = gtid; i < DEPTH * NG * NH * NP; i += NGT) { const int pp = i % NP, rest = i / NP;
          cf[(size_t)rest * 128 + 2 * pp] = f2bf(in_I_CRE[i]); cf[(size_t)rest * 128 + 2 * pp + 1] = f2bf(-in_I_CIM[i]); } }
    { bf16_t* sw = (bf16_t*)(ws + WS_SGUW);
      for (int i = gtid; i < DEPTH * SGH * 128 * 128; i += NGT) { const int s = i & 127, t = (i >> 7) & 127; sw[i] = (s <= t) ? f2bf(in_I_SGW[i]) : (bf16_t)0; } }
    { LAS float* scr = (LAS float*)(lds + wave * 16384);
      constexpr int I_IN = (DM / 64) * (DIN / 32), I_O = (DM / 64) * (DM / 32);
#pragma unroll 1
      for (int l = 0; l < DEPTH; ++l) { TrPair tp;
          tp.W0 = in_I_WIN + (size_t)l * DM * DIN; tp.T0 = (bf16_t*)(ws + WS_WIN) + (size_t)l * DIN * DM; tp.s0 = nullptr; tp.K0 = DM; tp.N0 = DIN; tp.n0 = I_IN;
          tp.W1 = in_I_WOUT + (size_t)l * DM * DM; tp.T1 = (bf16_t*)(ws + WS_WOUT) + (size_t)l * DM * DM; tp.s1 = in_I_MNG + l * DM; tp.K1 = DM; tp.N1 = DM; tp.n1 = I_O;
          tr_run(tp, scr, gw, NGW, lane); } }
}

__device__ __forceinline__ void phase_mod_h0(const PView& p, LAS unsigned char* lds, int tid, int lane, int wave) {
    const float* const in_I_ADAB = p.in[I_ADAB]; const float* const in_I_X = p.in[I_X];
    unsigned char* ws = p.ws;
    const int G = gridDim.x, gw = blockIdx.x * NWAVES + wave, NGW = G * NWAVES, gtid = blockIdx.x * NTHREADS + tid, NGT = G * NTHREADS;
    const float* part = (const float*)(ws + WS_MODPART); const float* ab = in_I_ADAB;
    for (int i = gtid; i < 2 * 6 * DM; i += NGT) { float s = ab[i];
#pragma unroll
        for (int ks = 0; ks < 16; ++ks) s += part[(size_t)ks * (2 * 6 * DM) + i];
        ((float*)(ws + WS_MOD))[i] = s; }
    LAS float* m0 = (LAS float*)lds;
    for (int i = tid; i < 2 * DM; i += NTHREADS) { float s = ab[i];
#pragma unroll
        for (int ks = 0; ks < 16; ++ks) s += part[(size_t)ks * (2 * 6 * DM) + i];
        m0[i] = s; }
    __syncthreads();
    f32x4 sc[8], sh[8];
#pragma unroll
    for (int j = 0; j < 8; ++j) { sh[j] = *(const LAS f32x4*)(m0 + 4 * lane + 256 * j); sc[j] = *(const LAS f32x4*)(m0 + DM + 4 * lane + 256 * j) + 1.0f; }
    const float* x = in_I_X; bf16_t* H = (bf16_t*)(ws + WS_H);
    f32x4 xn[8];
    if (gw < SEQ) {
#pragma unroll
        for (int j = 0; j < 8; ++j) xn[j] = __builtin_nontemporal_load((const GAS f32x4*)(x + (size_t)gw * DM + 4 * lane + 256 * j)); }
    for (int row = gw; row < SEQ; row += NGW) { f32x4 xc[8];
#pragma unroll
        for (int j = 0; j < 8; ++j) xc[j] = xn[j];
        if (row + NGW < SEQ) {
#pragma unroll
            for (int j = 0; j < 8; ++j) xn[j] = __builtin_nontemporal_load((const GAS f32x4*)(x + (size_t)(row + NGW) * DM + 4 * lane + 256 * j)); }
#pragma unroll
        for (int j = 0; j < 8; ++j) { const f32x4 h = xc[j] * sc[j] + sh[j];
            u32x2 w; w.x = cvt_pk_bf16(h[0], h[1]); w.y = cvt_pk_bf16(h[2], h[3]); *(GAS u32x2*)(H + (size_t)row * DM + 4 * lane + 256 * j) = w; } }
    __syncthreads();
}

__device__ __forceinline__ void phase_ln(const bool HAS_H, bf16_t* zx, float* dout, const float* g, const float* b, const float* scale, const float* shift, bf16_t* H, int lane, int wave) {
    const int gw = blockIdx.x * NWAVES + wave, NGW = gridDim.x * NWAVES;
    f32x4 gg[8], bb[8], sc[8], sh[8];
#pragma unroll
    for (int j = 0; j < 8; ++j) { const int c0 = 8 * lane + 512 * (j >> 1) + 4 * (j & 1);
        gg[j] = *(const GAS f32x4*)(g + c0); bb[j] = *(const GAS f32x4*)(b + c0);
        if (HAS_H) { sc[j] = *(const GAS f32x4*)(scale + c0) + 1.0f; sh[j] = *(const GAS f32x4*)(shift + c0); } }
    u32x4 wn[4];
    if (gw < SEQ) {
#pragma unroll
        for (int j = 0; j < 4; ++j) wn[j] = *(const GAS u32x4*)(zx + (size_t)gw * DM + 8 * lane + 512 * j); }
    for (int row = gw; row < SEQ; row += NGW) { bf16_t* zr = zx + (size_t)row * DM + 8 * lane;
        f32x4 v[8]; float s = 0.f;
        u32x4 wc_[4];
#pragma unroll
        for (int j = 0; j < 4; ++j) wc_[j] = wn[j];
        if (row + NGW < SEQ) {
#pragma unroll
            for (int j = 0; j < 4; ++j) wn[j] = *(const GAS u32x4*)(zr + (size_t)NGW * DM + 512 * j); }
#pragma unroll
        for (int j = 0; j < 4; ++j) { const u32x4 w = wc_[j];
            v[2 * j] = (f32x4){bf2f((unsigned short)(w.x & 0xffff)), bf2f((unsigned short)(w.x >> 16)), bf2f((unsigned short)(w.y & 0xffff)), bf2f((unsigned short)(w.y >> 16))};
            v[2 * j + 1] = (f32x4){bf2f((unsigned short)(w.z & 0xffff)), bf2f((unsigned short)(w.z >> 16)), bf2f((unsigned short)(w.w & 0xffff)), bf2f((unsigned short)(w.w >> 16))}; }
#pragma unroll
        for (int j = 0; j < 8; ++j) s += (v[j][0] + v[j][1]) + (v[j][2] + v[j][3]);
        const float mean = wave_sum(s) * (1.0f / DM); float s2 = 0.f;
#pragma unroll
        for (int j = 0; j < 8; ++j) { v[j] = v[j] - mean; s2 += (v[j][0] * v[j][0] + v[j][1] * v[j][1]) + (v[j][2] * v[j][2] + v[j][3] * v[j][3]); }
        const float rstd = 1.0f / sqrtf(wave_sum(s2) * (1.0f / DM) + LN_EPS);
#pragma unroll
        for (int j = 0; j < 4; ++j) { const f32x4 x0 = v[2 * j] * rstd * gg[2 * j] + bb[2 * j], x1 = v[2 * j + 1] * rstd * gg[2 * j + 1] + bb[2 * j + 1];
            if (HAS_H) { u32x4 w; w.x = cvt_pk_bf16(x0[0], x0[1]); w.y = cvt_pk_bf16(x0[2], x0[3]); w.z = cvt_pk_bf16(x1[0], x1[1]); w.w = cvt_pk_bf16(x1[2], x1[3]);
                *(GAS u32x4*)(zr + 512 * j) = w;
                const f32x4 h0 = x0 * sc[2 * j] + sh[2 * j], h1 = x1 * sc[2 * j + 1] + sh[2 * j + 1];
                u32x4 hw; hw.x = cvt_pk_bf16(h0[0], h0[1]); hw.y = cvt_pk_bf16(h0[2], h0[3]); hw.z = cvt_pk_bf16(h1[0], h1[1]); hw.w = cvt_pk_bf16(h1[2], h1[3]);
                *(GAS u32x4*)(H + (size_t)row * DM + 8 * lane + 512 * j) = hw; }
            else { float* orow = dout + (size_t)row * DM + 8 * lane + 512 * j; *(GAS f32x4*)(orow) = x0; *(GAS f32x4*)(orow + 4) = x1; } } }
}

__device__ __forceinline__ void phase_rmsnorm(unsigned char* ws, int l, int lane, int wave) {
    const int gw = blockIdx.x * NWAVES + wave, NGW = gridDim.x * NWAVES;
    bf16_t* Y = (bf16_t*)(ws + WS_Y); const float* rsp = (const float*)(ws + WS_RSP);
    u32x4 vn[4]; float p0n = 0.f, p1n = 0.f;
    if (gw < SEQ) { p0n = *(const GAS float*)(rsp + (size_t)lane * SEQ + gw); p1n = *(const GAS float*)(rsp + (size_t)(NG + (lane & 7)) * SEQ + gw);
#pragma unroll
        for (int j = 0; j < 4; ++j) vn[j] = *(const GAS u32x4*)(Y + (size_t)gw * DM + 8 * lane + 512 * j); }
    for (int row = gw; row < SEQ; row += NGW) {
        const float p0 = p0n, p1 = (lane < SGH) ? p1n : 0.f;
        bf16_t* yr = Y + (size_t)row * DM + 8 * lane;
        u32x4 v[4];
#pragma unroll
        for (int j = 0; j < 4; ++j) v[j] = vn[j];
        if (row + NGW < SEQ) { p0n = *(const GAS float*)(rsp + (size_t)lane * SEQ + row + NGW); p1n = *(const GAS float*)(rsp + (size_t)(NG + (lane & 7)) * SEQ + row + NGW);
#pragma unroll
            for (int j = 0; j < 4; ++j) vn[j] = *(const GAS u32x4*)(yr + (size_t)NGW * DM + 512 * j); }
        const float r0 = __builtin_amdgcn_rsqf(wave_sum(p0) * (1.0f / 1024.0f) + RMS_EPS), r1 = __builtin_amdgcn_rsqf(wave_sum(p1) * (1.0f / 1024.0f) + RMS_EPS);
#pragma unroll
        for (int j = 0; j < 4; ++j) { const float r = (j < 2) ? r0 : r1; u32x4 o;
#pragma unroll
            for (int e = 0; e < 4; ++e) { const unsigned w = v[j][e]; o[e] = cvt_pk_bf16(bf2f((unsigned short)(w & 0xffff)) * r, bf2f((unsigned short)(w >> 16)) * r); }
            *(GAS u32x4*)(yr + 512 * j) = o; } }
}

template <bool PB>
__device__ __forceinline__ void phase_s5(const PView& p, int l, LAS unsigned char* lds, int lane, int wave) {
    const float* const in_I_GLUB = p.in[I_GLUB]; const float* const in_I_GLUW = p.in[I_GLUW]; const float* const in_I_SD = p.in[I_SD];
    unsigned char* ws = p.ws;
    const int gw = blockIdx.x * NWAVES + wave, NGW = gridDim.x * NWAVES;
    const int q = lane >> 4, c = lane & 15;
    LAS unsigned* BuL = (LAS unsigned*)(lds + wave * S5_STRIDE);
    LAS unsigned* HL = (LAS unsigned*)(lds + wave * S5_STRIDE + 4352);
    const bf16_t* PROJ = (const bf16_t*)(ws + WS_PROJ);
    bf16_t* Y = (bf16_t*)(ws + WS_Y);
    long long* rs2 = (long long*)(ws + WS_RS2) + (size_t)(l * 2 + 0) * SEQ;
    f32x2* E = (f32x2*)(ws + WS_E);
    const bf16x8 zero8 = (bf16x8){0, 0, 0, 0, 0, 0, 0, 0};
    const f32x4 zero4 = (f32x4){0.f, 0.f, 0.f, 0.f};
    TrPair tp; const bool conv_first = wave >= 4;
    if (PB) { const float* const in_I_W1 = p.in[I_W1]; const float* const in_I_W2 = p.in[I_W2];
        tp.W0 = in_I_W1 + (size_t)l * DM * DFF; tp.T0 = (bf16_t*)(ws + WS_W1) + (size_t)l * DFF * DM; tp.s0 = nullptr; tp.K0 = DM; tp.N0 = DFF; tp.n0 = (DM / 64) * (DFF / 32);
        tp.W1 = in_I_W2 + (size_t)l * DFF * DM; tp.T1 = (bf16_t*)(ws + WS_W2) + (size_t)l * DM * DFF; tp.s1 = nullptr; tp.K1 = DFF; tp.N1 = DM; tp.n1 = (DFF / 64) * (DM / 32);
        if (conv_first) tr_run(tp, (LAS float*)(lds + wave * S5_STRIDE + 8704), gw, NGW, lane); }
    for (int item = gw; item < NG * NSEG; item += NGW) {
        const int g = item / NSEG, seg = item % NSEG, lg = l * NG + g;
        bf16x8 bbf[8];
#pragma unroll
        for (int i = 0; i < 8; ++i) bbf[i] = (q < 2) ? *(const GAS bf16x8*)((const bf16_t*)(ws + WS_BBF) + ((size_t)lg * 128 + 16 * i + c) * 16 + 8 * q) : zero8;
        const f32x2 av = ((const f32x2*)(ws + WS_AB))[lg * NP + lane];
        const float ar = av.x, ai = av.y;
        float hr = 0.f, hi = 0.f;
        bf16x8 cfr[4], dfr, glf[2]; float gb0[4], gb1[4];
        if (PB) {
#pragma unroll
            for (int kk = 0; kk < 4; ++kk) cfr[kk] = *(const GAS bf16x8*)((const bf16_t*)(ws + WS_CF) + ((size_t)lg * 16 + c) * 128 + 32 * kk + 8 * q);
            const bf16_t dv = f2bf(in_I_SD[lg * NH + c]);
#pragma unroll
            for (int j = 0; j < 8; ++j) dfr[j] = (q < 2 && 8 * q + j == c) ? (short)dv : (short)0;
#pragma unroll
            for (int t = 0; t < 2; ++t)
#pragma unroll
                for (int j = 0; j < 8; ++j) glf[t][j] = (j < 4) ? (short)f2bf(in_I_GLUW[((size_t)lg * NH + 4 * q + j) * 32 + 16 * t + c]) : (short)0;
#pragma unroll
            for (int r = 0; r < 4; ++r) { gb0[r] = in_I_GLUB[lg * 32 + 4 * q + r]; gb1[r] = in_I_GLUB[lg * 32 + 16 + 4 * q + r]; }
            const f32x2 as = ((const f32x2*)(ws + WS_ABS))[lg * NP + lane];
            f32x2 ev[NSEG - 1];
#pragma unroll
            for (int j = 0; j < NSEG - 1; ++j) ev[j] = (j < seg) ? *(const GAS f32x2*)(E + ((size_t)g * NSEG + j) * NP + lane) : (f32x2){0.f, 0.f};
#pragma unroll
            for (int j = 0; j < NSEG - 1; ++j) if (j < seg) { const float nr = fmaf(as.x, hr, fmaf(-as.y, hi, ev[j].x)), ni = fmaf(as.x, hi, fmaf(as.y, hr, ev[j].y)); hr = nr; hi = ni; }
        }
        const int t0 = seg * SEGLEN;
        const bf16_t* up = PROJ + (size_t)(t0 + c) * DIN + g * 16 + 8 * (q & 1);
        bf16x8 ufA = *(const GAS bf16x8*)up, ufB = *(const GAS bf16x8*)(up + (size_t)16 * DIN);
        asm volatile("" : "+v"(ufA), "+v"(ufB));
        for (int sc = 0; sc < SEGLEN / 16; ++sc) {
            const int pos0 = t0 + 16 * sc;
            const int scn = (sc + 2 < SEGLEN / 16) ? sc + 2 : SEGLEN / 16 - 1;
            const bf16x8 ufC = *(const GAS bf16x8*)(up + (size_t)scn * 16 * DIN);
            const bf16x8 uf = (q < 2) ? ufA : zero8;
#pragma unroll
            for (int i = 0; i < 8; ++i) { const f32x4 d = __builtin_amdgcn_mfma_f32_16x16x32_bf16(bbf[i], uf, zero4, 0, 0, 0);
                u32x2 w; w.x = cvt_pk_bf16(d[0], d[1]); w.y = cvt_pk_bf16(d[2], d[3]); *(LAS u32x2*)(BuL + c * 68 + 8 * i + 2 * q) = w; }
            LDS_WAIT();
            unsigned bu[16];
#pragma unroll
            for (int s = 0; s < 16; ++s) bu[s] = BuL[s * 68 + lane];
#pragma unroll
            for (int s = 0; s < 16; ++s) { const float bx = bf2f((unsigned short)(bu[s] & 0xffff)), by = __builtin_bit_cast(float, bu[s] & 0xffff0000u);
                const float nr = fmaf(ar, hr, fmaf(-ai, hi, bx)), ni = fmaf(ar, hi, fmaf(ai, hr, by)); hr = nr; hi = ni;
                if (PB) HL[s * 68 + lane] = cvt_pk_bf16(hr, hi); }
            LDS_WAIT();
            if (PB) {
                f32x4 y = zero4;
#pragma unroll
                for (int kk = 0; kk < 4; ++kk) { const bf16x8 hf = *(const LAS bf16x8*)((const LAS bf16_t*)HL + c * 136 + 32 * kk + 8 * q); y = __builtin_amdgcn_mfma_f32_16x16x32_bf16(cfr[kk], hf, y, 0, 0, 0); }
                y = __builtin_amdgcn_mfma_f32_16x16x32_bf16(dfr, uf, y, 0, 0, 0);
                bf16x8 gf = zero8;
                { const unsigned w0 = cvt_pk_bf16(gelu_tanh(y[0]), gelu_tanh(y[1])), w1 = cvt_pk_bf16(gelu_tanh(y[2]), gelu_tanh(y[3]));
                  gf[0] = (short)(w0 & 0xffff); gf[1] = (short)(w0 >> 16); gf[2] = (short)(w1 & 0xffff); gf[3] = (short)(w1 >> 16); }
                const f32x4 z0 = __builtin_amdgcn_mfma_f32_16x16x32_bf16(glf[0], gf, zero4, 0, 0, 0);
                const f32x4 z1 = __builtin_amdgcn_mfma_f32_16x16x32_bf16(glf[1], gf, zero4, 0, 0, 0);
                float o[4]; float ss = 0.f;
#pragma unroll
                for (int r = 0; r < 4; ++r) { o[r] = (z0[r] + gb0[r]) * sigmoidf_(z1[r] + gb1[r]); ss += o[r] * o[r]; }
                u32x2 w; w.x = cvt_pk_bf16(o[0], o[1]); w.y = cvt_pk_bf16(o[2], o[3]);
                *(GAS u32x2*)(Y + (size_t)(pos0 + c) * DM + g * 16 + 4 * q) = w;
                ss += __shfl_xor(ss, 16); ss += __shfl_xor(ss, 32);
                if (q == 0) fx_add(rs2 + pos0 + c, ss, FX_RS);
                LDS_WAIT();
            }
            ufA = ufB; ufB = ufC;
        }
        if (!PB) E[((size_t)g * NSEG + seg) * NP + lane] = (f32x2){hr, hi};
    }
    if (PB && !conv_first) tr_run(tp, (LAS float*)(lds + wave * S5_STRIDE + 8704), gw, NGW, lane);
}

__host__ __device__ constexpr int sgu_wpre(int tt) { int w = 0; for (int i = 0; i < tt; ++i) w += i / 2 + 1; return w; }
__device__ __forceinline__ void phase_sgu(const PView& p, int l, LAS unsigned char* lds, int tid, int lane, int wave) {
    const float* const in_I_SGB = p.in[I_SGB]; const float* const in_I_SLNB = p.in[I_SLNB]; const float* const in_I_SLNG = p.in[I_SLNG];
    unsigned char* ws = p.ws;
    const bf16_t* PROJ = (const bf16_t*)(ws + WS_PROJ);
    bf16_t* Y = (bf16_t*)(ws + WS_Y);
    long long* rs2 = (long long*)(ws + WS_RS2) + (size_t)(l * 2 + 1) * SEQ;
    LAS unsigned* VT = (LAS unsigned*)lds;
    LAS float* RED = (LAS float*)(lds + 36864);
    LAS bf16_t* WL = (LAS bf16_t*)(lds + 40960);
    const int q = lane >> 4, c = lane & 15;
    const int NIT = (SEQ / 128) * SGH, G = gridDim.x;
    const int rp = tid >> 3, ds = tid & 7;
    bf16x8 a0, a1, b0, b1;
    u32x2 uun[8];
    auto prefetch = [&](int item) { const int n = item >> 3, hd = item & 7;
        const bf16_t* vp = PROJ + (size_t)(n * 128 + 2 * rp) * DIN + 2048 + hd * 128 + 16 * ds;
        a0 = *(const GAS bf16x8*)vp; a1 = *(const GAS bf16x8*)(vp + 8); b0 = *(const GAS bf16x8*)(vp + DIN); b1 = *(const GAS bf16x8*)(vp + DIN + 8);
#pragma unroll
        for (int tt = 0; tt < 8; ++tt) uun[tt] = *(const GAS u32x2*)(PROJ + (size_t)(n * 128 + 16 * tt + c) * DIN + 1024 + hd * 128 + 16 * wave + 4 * q); };
    if ((int)blockIdx.x < NIT) prefetch(blockIdx.x);
    int hd_loaded = -1; f32x4 lgv[4], lbv[4]; float bsp[8];
    for (int item = blockIdx.x; item < NIT; item += G) {
        const int n = item >> 3, hd = item & 7;
        if (hd != hd_loaded) {
            if (hd_loaded >= 0) { LDS_WAIT(); __builtin_amdgcn_s_barrier(); }
            const bf16_t* wb = (const bf16_t*)(ws + WS_SGUW) + (size_t)(l * SGH + hd) * 128 * 128;
#pragma unroll
            for (int i = 0; i < 4; ++i) { const int e = tid + NTHREADS * i, t = e >> 4, s8 = e & 15;
                *(LAS bf16x8*)(WL + t * 136 + 8 * s8) = *(const GAS bf16x8*)(wb + (size_t)t * 128 + 8 * s8); }
#pragma unroll
            for (int j4 = 0; j4 < 4; ++j4) { lgv[j4] = *(const GAS f32x4*)(in_I_SLNG + l * 1024 + hd * 128 + 16 * ds + 4 * j4); lbv[j4] = *(const GAS f32x4*)(in_I_SLNB + l * 1024 + hd * 128 + 16 * ds + 4 * j4); }
#pragma unroll
            for (int tt = 0; tt < 8; ++tt) bsp[tt] = *(const GAS float*)(in_I_SGB + (l * SGH + hd) * 128 + 16 * tt + c);
            hd_loaded = hd; }
        u32x2 uu[8];
        { float v0[16], v1[16];
#pragma unroll
          for (int j = 0; j < 8; ++j) { v0[j] = bf2f((unsigned short)a0[j]); v0[8 + j] = bf2f((unsigned short)a1[j]); v1[j] = bf2f((unsigned short)b0[j]); v1[8 + j] = bf2f((unsigned short)b1[j]); }
#pragma unroll
          for (int tt = 0; tt < 8; ++tt) uu[tt] = uun[tt];
          if (item + G < NIT) prefetch(item + G);
          float s0 = 0.f, s1 = 0.f;
#pragma unroll
          for (int j = 0; j < 16; ++j) { s0 += v0[j]; s1 += v1[j]; }
#pragma unroll
          for (int o = 1; o < 8; o <<= 1) { s0 += __shfl_xor(s0, o); s1 += __shfl_xor(s1, o); }
          const float m0 = s0 * (1.0f / 128.0f), m1 = s1 * (1.0f / 128.0f);
          float q0 = 0.f, q1 = 0.f;
#pragma unroll
          for (int j = 0; j < 16; ++j) { v0[j] -= m0; v1[j] -= m1; q0 += v0[j] * v0[j]; q1 += v1[j] * v1[j]; }
#pragma unroll
          for (int o = 1; o < 8; o <<= 1) { q0 += __shfl_xor(q0, o); q1 += __shfl_xor(q1, o); }
          const float r0 = 1.0f / sqrtf(q0 * (1.0f / 128.0f) + LN_EPS), r1 = 1.0f / sqrtf(q1 * (1.0f / 128.0f) + LN_EPS);
#pragma unroll
          for (int j4 = 0; j4 < 4; ++j4)
#pragma unroll
              for (int e = 0; e < 4; ++e) { const int j = 4 * j4 + e; VT[(16 * ds + j) * 68 + rp] = cvt_pk_bf16(v0[j] * r0 * lgv[j4][e] + lbv[j4][e], v1[j] * r1 * lgv[j4][e] + lbv[j4][e]); } }
        LDS_WAIT(); __builtin_amdgcn_s_barrier(); asm volatile("" ::: "memory");
        { bf16x8 af[4];
#pragma unroll
          for (int kk = 0; kk < 4; ++kk) af[kk] = *(const LAS bf16x8*)((const LAS bf16_t*)VT + (16 * wave + c) * 136 + 32 * kk + 8 * q);
#pragma unroll
          for (int tt = 0; tt < 8; ++tt) { f32x4 acc = (f32x4){0.f, 0.f, 0.f, 0.f};
#pragma unroll
              for (int kk = 0; kk < 4; ++kk) if (kk <= tt / 2) { const bf16x8 wf = *(const LAS bf16x8*)(WL + (16 * tt + c) * 136 + 32 * kk + 8 * q); acc = __builtin_amdgcn_mfma_f32_16x16x32_bf16(af[kk], wf, acc, 0, 0, 0); }
              const int t = n * 128 + 16 * tt + c;
              float o[4];
              o[0] = bf2f((unsigned short)(uu[tt].x & 0xffff)) * (acc[0] + bsp[tt]); o[1] = bf2f((unsigned short)(uu[tt].x >> 16)) * (acc[1] + bsp[tt]);
              o[2] = bf2f((unsigned short)(uu[tt].y & 0xffff)) * (acc[2] + bsp[tt]); o[3] = bf2f((unsigned short)(uu[tt].y >> 16)) * (acc[3] + bsp[tt]);
              u32x2 wv; wv.x = cvt_pk_bf16(o[0], o[1]); wv.y = cvt_pk_bf16(o[2], o[3]);
              *(GAS u32x2*)(Y + (size_t)t * DM + 1024 + hd * 128 + 16 * wave + 4 * q) = wv;
              float ss = (o[0] * o[0] + o[1] * o[1]) + (o[2] * o[2] + o[3] * o[3]);
              ss += __shfl_xor(ss, 16); ss += __shfl_xor(ss, 32);
              if (q == 0) RED[wave * 128 + 16 * tt + c] = ss; } }
        LDS_WAIT(); __builtin_amdgcn_s_barrier(); asm volatile("" ::: "memory");
        if (tid < 128) { float a = 0.f;
#pragma unroll
            for (int w = 0; w < 8; ++w) a += RED[w * 128 + tid];
            fx_add(rs2 + n * 128 + tid, a, FX_RS); }
    }
}

#define GSYNC() do { __builtin_amdgcn_fence(__ATOMIC_RELEASE, "agent"); asm volatile("s_waitcnt vmcnt(0) lgkmcnt(0)" ::: "memory"); grid.sync(); \
    __builtin_amdgcn_fence(__ATOMIC_ACQUIRE, "agent"); asm volatile("s_waitcnt vmcnt(0)" ::: "memory"); __syncthreads(); } while (0)
__global__ void __launch_bounds__(NTHREADS, 2) mk_fwd(Params p) {
    extern __shared__ __attribute__((aligned(16))) unsigned char lds_raw[];
    LAS unsigned char* lds0 = (LAS unsigned char*)lds_raw;
    cg::grid_group grid = cg::this_grid();
    if (threadIdx.x < 27) *(LAS unsigned long long*)(lds0 + PTR_OFF + 8 * threadIdx.x) = (unsigned long long)p.in[threadIdx.x];
    if (threadIdx.x < 2) ((LAS unsigned*)(lds0 + MISC_OFF))[threadIdx.x] = 0u;
    __syncthreads();
    const XcdBarrier xbar = xcd_barrier_post((unsigned*)(p.ws + WS_BAR), (volatile LAS unsigned*)(lds0 + MISC_OFF));
    const int G = gridDim.x;
    { const int tid = threadIdx.x, lane = tid & 63, wave = __builtin_amdgcn_readfirstlane(tid >> 6);
      PView pv; pv.in.lds = lds0; pv.out = p.out; pv.ws = p.ws;
#ifndef SK_P0
      phase_prologue(pv, lds0, tid, lane, wave);
#endif
      if (p.ws == nullptr) grid.sync();
      xcd_barrier(xbar);
#ifndef SK_P0C
      phase_mod_h0(pv, lds0, tid, lane, wave);
#endif
      xcd_barrier(xbar); }

    constexpr int NSTEP = 8;
#pragma unroll 1
    for (int step = 0; step < DEPTH * NSTEP; ++step) {
        const int l = step / NSTEP, k = step % NSTEP;
        unsigned char* ws = p.ws; float* out = p.out; int tid = threadIdx.x; LAS unsigned char* lds = lds0;
        asm volatile("" : "+s"(ws), "+s"(out), "+v"(tid), "+s"(lds));
        ASSUME_GLOBAL(ws); ASSUME_GLOBAL(out);
        const int lane = tid & 63, wave = __builtin_amdgcn_readfirstlane(tid >> 6);
        PView pv; pv.in.lds = lds; pv.out = out; pv.ws = ws;
        const float* MOD = (const float*)(ws + WS_MOD);
        bf16_t* H = (bf16_t*)(ws + WS_H);
        const float* mod = MOD + (size_t)l * 6 * DM;
        if (k == 0 || k == 3 || k == 5 || k == 6) {
            pg8::Gemm g; EpiAll E; E.O = nullptr; E.ldc = 0; E.xin = nullptr; E.gate = nullptr; E.rs2 = nullptr;
            if (k == 0) {
                g = pg8::Gemm{H, (const bf16_t*)(ws + WS_WIN) + (size_t)l * DIN * DM, SEQ, DIN, DM};
                E.mode = 0; E.O = (bf16_t*)(ws + WS_PROJ); E.ldc = DIN;
            } else if (k == 3) {
                g = pg8::Gemm{(const bf16_t*)(ws + WS_Y), (const bf16_t*)(ws + WS_WOUT) + (size_t)l * DM * DM, SEQ, DM, DM};
                E.mode = 1; E.O = (bf16_t*)(ws + WS_ZX); E.ldc = DM; if (l == 0) E.xin = pv.in[I_X]; E.gate = mod + 2 * DM; E.rs2 = (const long long*)(ws + WS_RS2) + (size_t)l * 2 * SEQ;
            } else if (k == 5) {
                g = pg8::Gemm{H, (const bf16_t*)(ws + WS_W1) + (size_t)l * DFF * DM, SEQ, DFF, DM};
                E.mode = 2; E.O = (bf16_t*)(ws + WS_BIG); E.ldc = DFF;
            } else {
                g = pg8::Gemm{(const bf16_t*)(ws + WS_BIG), (const bf16_t*)(ws + WS_W2) + (size_t)l * DM * DFF, SEQ, DM, DFF};
                E.mode = 1; E.O = (bf16_t*)(ws + WS_ZX); E.ldc = DM; E.gate = mod + 5 * DM;
            }
            pg8::StaticOrder S; S.init(g.M, g.N, G, (int)blockIdx.x, k == 6 ? 1 : 0);
#ifndef SK_G
            pg8::gemm_phase<EpiAll, pg8::StaticOrder>(lds, g, S, E, tid);
#endif
        } else if (k == 1) {
#ifndef SK_S5A
            phase_s5<false>(pv, l, lds, lane, wave);
#endif
            __syncthreads();
#ifndef SK_SGU
            phase_sgu(pv, l, lds, tid, lane, wave);
#endif
        } else if (k == 2) {
#ifndef SK_S5B
            phase_s5<true>(pv, l, lds, lane, wave);
#endif
        } else {
#ifndef SK_LN
            const bool has_h = (k == 4) || (l + 1 < DEPTH);
            const float* modn = MOD + (size_t)(l + 1) * 6 * DM;
            const float* gp = pv.in[k == 4 ? I_LN1G : I_LN2G] + l * DM; const float* bp = pv.in[k == 4 ? I_LN1B : I_LN2B] + l * DM;
            phase_ln(has_h, (bf16_t*)(ws + WS_ZX), out, gp, bp, k == 4 ? mod + 4 * DM : modn + 1 * DM, k == 4 ? mod + 3 * DM : modn, H, lane, wave);
#endif
        }
        if (step + 1 < DEPTH * NSTEP) { XcdBarrier xb; xb.bar = (unsigned*)(ws + WS_BAR); xb.x = xb_xcc_id(); xb.st = (volatile LAS unsigned*)(lds + MISC_OFF); xcd_barrier(xb); }
    }
}

extern "C" void kernel_launch(void* const* d_in, const int* in_sizes, int n_in, void* d_out, int out_size, void* d_ws, size_t ws_size, hipStream_t stream) {
    static int grid = 0;
    if (grid == 0) {
        if (n_in != 27 || out_size != SEQ * DM || ws_size < WS_END) { fprintf(stderr, "kernel_launch: unexpected shapes (n_in %d, out %d, ws %zu)\n", n_in, out_size, ws_size); grid = -1; return; }
        int dev = 0, cus = 0, per_cu = 0;
(void)hipGetDevice(&dev);
        (void)hipDeviceGetAttribute(&cus, hipDeviceAttributeMultiprocessorCount, dev);
        if (hipFuncSetAttribute((const void*)mk_fwd, hipFuncAttributeMaxDynamicSharedMemorySize, LDS_BYTES) != hipSuccess) { fprintf(stderr, "kernel_launch: hipFuncSetAttribute failed\n"); grid = -1; return; }
        if (hipOccupancyMaxActiveBlocksPerMultiprocessor(&per_cu, (const void*)mk_fwd, NTHREADS, LDS_BYTES) != hipSuccess || per_cu < 1) { fprintf(stderr, "kernel_launch: occupancy query says %d\n", per_cu); per_cu = 1; }
        (void)hipGetLastError();
        grid = cus * per_cu;
        if (grid > 256) grid = 256;
    }
    if (grid < 0) return;
    Params p{};
    for (int i = 0; i < 27; ++i) p.in[i] = (const float*)d_in[i];
    p.out = (float*)d_out; p.ws = (unsigned char*)d_ws;
    if (hipMemsetAsync((char*)d_ws + WS_BAR, 0, XCD_BAR_WORDS * 4, stream) != hipSuccess) { fprintf(stderr, "kernel_launch: memset failed\n"); return; }
    void* args[] = {&p};
    hipError_t e = hipLaunchCooperativeKernel((const void*)mk_fwd, dim3(grid), dim3(NTHREADS), args, LDS_BYTES, stream);
    if (e != hipSuccess) fprintf(stderr, "cooperative launch failed: %s (grid %d)\n", hipGetErrorString(e), grid);
}
```

```cpp
#include <hip/hip_runtime.h>
#include <hip/hip_cooperative_groups.h>
#include <cstdio>
namespace cg = cooperative_groups;

#define LAS __attribute__((address_space(3)))
#define GAS __attribute__((address_space(1)))
typedef unsigned short bf16_t;
typedef short bf16x8 __attribute__((ext_vector_type(8)));
typedef float f32x4 __attribute__((ext_vector_type(4)));
typedef float f32x2 __attribute__((ext_vector_type(2)));
typedef unsigned u32x4 __attribute__((ext_vector_type(4)));
typedef unsigned u32x2 __attribute__((ext_vector_type(2)));

constexpr int SEQ = 16384, DM = 2048, DIN = 3072, DFF = 8192, DEPTH = 2;
constexpr int NG = 64, NP = 64, NH = 16;
constexpr int SGH = 8;
constexpr float ALPHA = 1.4142135623730951f;
constexpr float LN_EPS = 1e-5f, RMS_EPS = 1e-6f;
constexpr int NTHREADS = 512, NWAVES = 8;
constexpr int LDS_BYTES = 147456;
constexpr int SEGLEN = 512, NSEG = SEQ / SEGLEN;

constexpr size_t MiB = 1u << 20;
constexpr size_t WS_WIN = 0;
constexpr size_t WS_WOUT = 24 * MiB;
constexpr size_t WS_W1 = 40 * MiB;
constexpr size_t WS_W2 = 104 * MiB;
constexpr size_t WS_H = 168 * MiB;
constexpr size_t WS_BIG = 232 * MiB;
constexpr size_t WS_PROJ = WS_BIG;
constexpr size_t WS_Y = WS_BIG + 96 * MiB;
constexpr size_t WS_SMALL = 488 * MiB;
constexpr size_t WS_MODPART = WS_SMALL;
constexpr size_t WS_MOD = WS_SMALL + 2 * MiB;
constexpr size_t WS_AB = WS_SMALL + 3 * MiB;
constexpr size_t WS_ABS = WS_AB + 65536;
constexpr size_t WS_BBF = WS_SMALL + 4 * MiB;
constexpr size_t WS_CF = WS_BBF + 512 * 1024;
constexpr size_t WS_SGUW = WS_SMALL + 5 * MiB;
constexpr size_t WS_E = WS_SMALL + 6 * MiB;
constexpr size_t WS_RS = WS_SMALL + 7 * MiB;
constexpr size_t WS_BAR = WS_SMALL + 7 * MiB + 512 * 1024;
constexpr size_t WS_ZX = WS_SMALL + 8 * MiB;
constexpr size_t WS_RSP = WS_ZX + 64 * MiB;
constexpr size_t WS_RS2 = WS_RSP + 6 * MiB;
constexpr size_t WS_END = WS_RSP + 8 * MiB;

typedef __bf16 bf16x2_t __attribute__((ext_vector_type(2)));
__device__ __forceinline__ unsigned cvt_pk_bf16(float lo, float hi) { const f32x2 v = {lo, hi}; const bf16x2_t b = __builtin_convertvector(v, bf16x2_t); return __builtin_bit_cast(unsigned, b); }
__device__ __forceinline__ bf16_t f2bf(float f) { unsigned u = __builtin_bit_cast(unsigned, f); return (bf16_t)((u + 0x7fffu + ((u >> 16) & 1u)) >> 16); }
__device__ __forceinline__ float bf2f(unsigned short b) { return __builtin_bit_cast(float, ((unsigned)b) << 16); }
__device__ __forceinline__ float gelu_tanh(float x) {
    const float u = x * (1.0f + 0.044715f * x * x);
    const float e = __builtin_amdgcn_exp2f(-2.3022082f * u);
    return x * __builtin_amdgcn_rcpf(1.0f + e);
}
__device__ __forceinline__ float sigmoidf_(float x) { return __builtin_amdgcn_rcpf(1.0f + __builtin_amdgcn_exp2f(-1.44269504f * x)); }
__device__ __forceinline__ float wave_sum(float v) {
#pragma unroll
    for (int o = 1; o < 64; o <<= 1) v += __shfl_xor(v, o);
    return v;
}
#if defined(__HIP_DEVICE_COMPILE__)
#define ASSUME_GLOBAL(p) do { __builtin_assume(!__builtin_amdgcn_is_shared((const void*)(p))); __builtin_assume(!__builtin_amdgcn_is_private((const void*)(p))); } while (0)
#else
#define ASSUME_GLOBAL(p) do { } while (0)
#endif
constexpr float FX_RS = 16777216.0f, FX_RS_INV = 1.0f / 16777216.0f;
__device__ __forceinline__ void fx_add(long long* p, float v, float scale) { __hip_atomic_fetch_add((GAS long long*)p, (long long)__float2ll_rn(v * scale), __ATOMIC_RELAXED, __HIP_MEMORY_SCOPE_AGENT); }
__device__ __forceinline__ float fx_get(const long long* p, float inv) { return (float)(*(const GAS long long*)p) * inv; }
#define LDS_WAIT() asm volatile("s_waitcnt lgkmcnt(0)" ::: "memory")

#define XB_TMO      128
#define XB_XCNT(j)  (256  + 64 * (j))
#define XB_XSUB(j)  (1280 + 64 * (j))
#define XB_XGEN(j)  (2304 + 64 * (j))
#define XB_TOP      3328
#define XB_TOPGEN   3392
#define XCD_BAR_WORDS 3456
#define XB_SPIN_CAP (1u << 20)
__device__ __forceinline__ unsigned xb_ld(unsigned* p)              { return __hip_atomic_load(p, __ATOMIC_RELAXED, __HIP_MEMORY_SCOPE_AGENT); }
__device__ __forceinline__ unsigned xb_add(unsigned* p, unsigned v) { return __hip_atomic_fetch_add(p, v, __ATOMIC_RELAXED, __HIP_MEMORY_SCOPE_AGENT); }
__device__ __forceinline__ unsigned xb_xcc_id() { return (unsigned)__builtin_amdgcn_s_getreg((3 << 11) | 20) & 0xFu; }
#define XB_SPIN(cond, bar) do { unsigned _sp = 0; while (cond) { __builtin_amdgcn_s_sleep(1); \
    if ((++_sp & 255u) == 0u) { if (xb_ld(&(bar)[XB_TMO])) break; if (_sp > XB_SPIN_CAP) { atomicAdd(&(bar)[XB_TMO], 1u); break; } } } } while (0)
struct XcdBarrier { unsigned* bar; unsigned x; volatile LAS unsigned* st; };
__device__ __forceinline__ XcdBarrier xcd_barrier_post(unsigned* bar, volatile LAS unsigned* st) {
    XcdBarrier b; b.bar = bar; b.x = xb_xcc_id(); b.st = st;
    if (threadIdx.x == 0) (void)xb_add(&bar[XB_XCNT(b.x)], 1u);
    return b;
}
__device__ __forceinline__ void xcd_barrier_complete(unsigned* bar, unsigned x, unsigned& nloc, unsigned& nx) {
    const unsigned G = gridDim.x * gridDim.y * gridDim.z;
    unsigned sum, cnt, mine, sp = 0u;
    for (;;) {
        sum = 0u; cnt = 0u; mine = 0u;
#pragma unroll
        for (unsigned j = 0; j < 16; ++j) { const unsigned c = xb_ld(&bar[XB_XCNT(j)]); sum += c; cnt += (c > 0u) ? 1u : 0u; mine = (j == x) ? c : mine; }
        if (sum == G) break;
        __builtin_amdgcn_s_sleep(1);
        if ((++sp & 255u) == 0u) { if (xb_ld(&bar[XB_TMO])) break; if (sp > XB_SPIN_CAP) { atomicAdd(&bar[XB_TMO], 1u); break; } }
    }
    nloc = mine > 0u ? mine : 1u; nx = cnt > 0u ? cnt : 1u;
}
__device__ __forceinline__ void xcd_barrier(const XcdBarrier& b) {
    asm volatile("s_waitcnt vmcnt(0) lgkmcnt(0)" ::: "memory");
    __syncthreads();
    if (threadIdx.x == 0) {
        unsigned* bar = b.bar;
        __builtin_amdgcn_s_waitcnt(0);
        unsigned nloc = b.st[0], nx = b.st[1];
        if (nloc == 0u) { xcd_barrier_complete(bar, b.x, nloc, nx); b.st[0] = nloc; b.st[1] = nx; }
        const unsigned old = xb_add(&bar[XB_XSUB(b.x)], 1u);
        const unsigned gen = old / nloc;
        if (old + 1u == (gen + 1u) * nloc) {
            __builtin_amdgcn_fence(__ATOMIC_RELEASE, "agent");
            asm volatile("s_waitcnt vmcnt(0)" ::: "memory");
            const unsigned og = xb_add(&bar[XB_TOP], 1u);
            const unsigned tg = og / nx;
            if (og + 1u == (tg + 1u) * nx) xb_add(&bar[XB_TOPGEN], 1u);
            else XB_SPIN(xb_ld(&bar[XB_TOPGEN]) == tg, bar);
            __builtin_amdgcn_fence(__ATOMIC_ACQUIRE, "agent");
            xb_add(&bar[XB_XGEN(b.x)], 1u);
            asm volatile("s_waitcnt vmcnt(0)" ::: "memory");
        } else {
            XB_SPIN(xb_ld(&bar[XB_XGEN(b.x)]) == gen, bar);
            __builtin_amdgcn_fence(__ATOMIC_ACQUIRE, "agent");
            asm volatile("s_waitcnt vmcnt(0)" ::: "memory");
        }
    }
    __syncthreads();
}

namespace pg8 {
constexpr int BM = 256, BK = 64, HALF = 128, HTB = HALF * BK * 2, STAGE_BYTES = 8 * HTB, NXCD = 8, WGM = 4;
__host__ __device__ __forceinline__ int lds_byte(int r, int c) { const int st = (r >> 4) * 2 + (c >> 5), rr = r & 15, cc = c & 31, ob = rr * 64 + cc * 2; return st * 1024 + (ob ^ (((ob >> 9) & 1) << 5)); }
__host__ __device__ __forceinline__ void stage_rc(int b, int& R, int& C) { const int st = b / 1024, sb = b % 1024, swz = sb ^ (((sb >> 9) & 1) << 5); R = (st >> 1) * 16 + swz / 64; C = (st & 1) * 32 + (swz % 64) / 2; }
__host__ __device__ __forceinline__ int perm32(int rho) { const int n = rho >> 4, i = rho & 15; return 8 * (i >> 2) + 4 * n + (i & 3); }
struct Unit { int pm, pn; };
struct Gemm { const bf16_t* A; const bf16_t* Bt; int M, N, K; };
struct StaticOrder {
    int nM, nN, nwg, G, c, rev;
    __device__ void init(int M, int N, int G_, int c_, int rev_ = 0) { nM = M / BM; nN = N / BM; nwg = nM * nN; G = G_; c = c_; rev = rev_; }
    __device__ bool next(int i, Unit& u) const {
        const long L = (long)i * G + c; if (L >= nwg) return false;
        int wgid = (int)L; { const int q = nwg / NXCD, r = nwg % NXCD, xcd = wgid % NXCD, off = wgid / NXCD; wgid = (xcd < r ? xcd * (q + 1) : r * (q + 1) + (xcd - r) * q) + off; }
        const int nig = WGM * nN, gid = wgid / nig, fm = gid * WGM, gsz = (nM - fm) < WGM ? (nM - fm) : WGM;
        u.pm = fm + ((wgid % nig) % gsz); u.pn = (wgid % nig) / gsz; if (rev) u.pm = nM - 1 - u.pm; return true;
    }
    __device__ __forceinline__ void a_ready(const Unit&) const {}
    __device__ __forceinline__ void done(const Unit&) const {}
};

template <class Epi, class Sched>
__device__ __forceinline__ void gemm_phase(LAS unsigned char* lds, const Gemm g, const Sched& S, const Epi& E, const int tid) {
    const int wid = __builtin_amdgcn_readfirstlane(tid >> 6), lane = tid & 63, wr = wid >> 2, wc = wid & 3, fr = lane & 15, fq = lane >> 4;
    const int K = g.K, nt = K / BK;
    unsigned voffA[2], voffB[2];
#pragma unroll
    for (int i = 0; i < 2; ++i) { int R, C; stage_rc(tid * 16 + i * 8192, R, C); const int Rb = (R & ~31) + perm32(R & 31);
        voffA[i] = (unsigned)(R * K + C) * 2u; voffB[i] = (unsigned)(Rb * K + C) * 2u; }
    const size_t kstep = (size_t)(BK * 2);
    const size_t hstep = (size_t)HALF * K * 2;
    const size_t tstep = 2 * hstep;
    const unsigned ldsw = (unsigned)wid * 1024u;
    const int aoff = lds_byte(wr * 64 + fr, fq * 8), boff = lds_byte(wc * 32 + fr, fq * 8);
#define PG8_SA(b, h) (((b) * 2 + (h)) * HTB)
#define PG8_SB(b, h) ((4 + (b) * 2 + (h)) * HTB)
#define PG8_STAGE(bufoff, gbase, voff) do { _Pragma("unroll") for (int _i = 0; _i < 2; ++_i) \
        __builtin_amdgcn_global_load_lds((const unsigned*)((const char*)(gbase) + (voff)[_i]), (LAS unsigned*)(lds + (bufoff) + ldsw + _i * 8192), 16, 0, 0); } while (0)
#define PG8_LDA(dst, b, h) do { _Pragma("unroll") for (int m = 0; m < 4; ++m) _Pragma("unroll") for (int k = 0; k < 2; ++k) dst[m][k] = *(const LAS bf16x8*)(lds + PG8_SA(b, h) + aoff + m * 2048 + k * 1024); } while (0)
#define PG8_LDB(dst, b, h) do { _Pragma("unroll") for (int n = 0; n < 2; ++n) _Pragma("unroll") for (int k = 0; k < 2; ++k) dst[n][k] = *(const LAS bf16x8*)(lds + PG8_SB(b, h) + boff + n * 2048 + k * 1024); } while (0)
#define PG8_MMA(ai, bj, At, Bt) do { __builtin_amdgcn_s_setprio(1); _Pragma("unroll") for (int m = 0; m < 4; ++m) _Pragma("unroll") for (int n = 0; n < 2; ++n) _Pragma("unroll") for (int k = 0; k < 2; ++k) \
        acc[ai][bj][m][n] = __builtin_amdgcn_mfma_f32_16x16x32_bf16(Bt[n][k], At[m][k], acc[ai][bj][m][n], 0, 0, 0); __builtin_amdgcn_s_setprio(0); } while (0)
#define PG8_WAIT_V(n) asm volatile("s_waitcnt vmcnt(" #n ")" ::: "memory")
#define PG8_WAIT_L(n) asm volatile("s_waitcnt lgkmcnt(" #n ")" ::: "memory")
#define PG8_BAR __builtin_amdgcn_s_barrier()
#define PG8_SCHED __builtin_amdgcn_sched_barrier(0)
    Unit cur, nxt; int ui = 0;
    if (!S.next(0, cur)) return;
    f32x4 acc[2][2][4][2];
#pragma unroll
    for (int a = 0; a < 2; ++a)
#pragma unroll
        for (int b = 0; b < 2; ++b)
#pragma unroll
            for (int m = 0; m < 4; ++m)
#pragma unroll
                for (int n = 0; n < 2; ++n) acc[a][b][m][n] = (f32x4){0.f, 0.f, 0.f, 0.f};
    bf16x8 At[4][2], B0[2][2], B1[2][2];
    const char* cA = (const char*)g.A + (size_t)cur.pm * tstep; const char* cB = (const char*)g.Bt + (size_t)cur.pn * tstep;
    S.a_ready(cur);
    PG8_STAGE(PG8_SB(0, 0), cB, voffB); PG8_STAGE(PG8_SA(0, 0), cA, voffA); PG8_STAGE(PG8_SB(0, 1), cB + hstep, voffB); PG8_STAGE(PG8_SA(0, 1), cA + hstep, voffA);
    if (wr == 1) PG8_BAR;
    PG8_WAIT_V(4); PG8_BAR;
    PG8_STAGE(PG8_SB(1, 0), cB + kstep, voffB); PG8_STAGE(PG8_SA(1, 0), cA + kstep, voffA); PG8_STAGE(PG8_SB(1, 1), cB + hstep + kstep, voffB);
    PG8_WAIT_V(6); PG8_BAR;
    for (;;) {
        const bool has_next = S.next(ui + 1, nxt);
        const char* nA = has_next ? (const char*)g.A + (size_t)nxt.pm * tstep : cA; const char* nB = has_next ? (const char*)g.Bt + (size_t)nxt.pn * tstep : cB;
        for (int t = 0; t < nt; t += 2) {
            const bool last = (t == nt - 2);
            const char* a1 = cA + (size_t)(t + 1) * kstep;
            const char* a2 = last ? nA : cA + (size_t)(t + 2) * kstep; const char* b2 = last ? nB : cB + (size_t)(t + 2) * kstep;
            const char* a3 = a2 + kstep; const char* b3 = b2 + kstep;
            if (last && has_next) S.a_ready(nxt);
            if (E.rs2 && t == nt / 2) { PG8_SCHED; E.mid(acc, cur, wr, fr); PG8_SCHED; }
            PG8_LDB(B0, 0, 0); PG8_SCHED; PG8_LDA(At, 0, 0); PG8_STAGE(PG8_SA(1, 1), a1 + hstep, voffA);
            PG8_WAIT_L(8); PG8_BAR; PG8_WAIT_L(0); PG8_MMA(0, 0, At, B0); PG8_BAR; PG8_SCHED;
            PG8_LDB(B1, 0, 1); PG8_STAGE(PG8_SB(0, 0), b2, voffB);
            PG8_BAR; PG8_WAIT_L(0); PG8_MMA(0, 1, At, B1); PG8_BAR;
            PG8_LDA(At, 0, 1); PG8_STAGE(PG8_SA(0, 0), a2, voffA);
            PG8_BAR; PG8_WAIT_L(0); PG8_MMA(1, 0, At, B0); PG8_BAR; PG8_SCHED;
            PG8_STAGE(PG8_SB(0, 1), b2 + hstep, voffB);
            PG8_WAIT_V(6); PG8_BAR; PG8_MMA(1, 1, At, B1); PG8_BAR;
            PG8_LDB(B0, 1, 0); PG8_SCHED; PG8_LDA(At, 1, 0); PG8_STAGE(PG8_SA(0, 1), a2 + hstep, voffA);
            PG8_WAIT_L(8); PG8_BAR; PG8_WAIT_L(0); PG8_MMA(0, 0, At, B0); PG8_BAR; PG8_SCHED;
            PG8_LDB(B1, 1, 1); PG8_STAGE(PG8_SB(1, 0), b3, voffB);
            PG8_BAR; PG8_WAIT_L(0); PG8_MMA(0, 1, At, B1); PG8_BAR;
            PG8_LDA(At, 1, 1); PG8_STAGE(PG8_SA(1, 0), a3, voffA);
            PG8_BAR; PG8_WAIT_L(0); PG8_MMA(1, 0, At, B0); PG8_BAR; PG8_SCHED;
            PG8_STAGE(PG8_SB(1, 1), b3 + hstep, voffB);
            PG8_WAIT_V(6); PG8_BAR; PG8_MMA(1, 1, At, B1); PG8_BAR;
        }
        E(acc, cur, wr, wc, fr, fq); S.done(cur);
        if (!has_next) break;
#pragma unroll
        for (int a = 0; a < 2; ++a)
#pragma unroll
            for (int b = 0; b < 2; ++b)
#pragma unroll
                for (int m = 0; m < 4; ++m)
#pragma unroll
                    for (int n = 0; n < 2; ++n) acc[a][b][m][n] = (f32x4){0.f, 0.f, 0.f, 0.f};
        cur = nxt; cA = nA; cB = nB; ++ui;
    }
    PG8_WAIT_V(0);
    if (wr == 0) PG8_BAR;
    PG8_BAR;
#undef PG8_SA
#undef PG8_SB
#undef PG8_STAGE
#undef PG8_LDA
#undef PG8_LDB
#undef PG8_MMA
#undef PG8_WAIT_V
#undef PG8_WAIT_L
#undef PG8_BAR
#undef PG8_SCHED
}
}

struct EpiAll {
    int mode;
    bf16_t* O; int ldc;
    const float* xin; const float* gate;
    const long long* rs2;
    __device__ __forceinline__ void mid(f32x4 (&acc)[2][2][4][2], const pg8::Unit& u, int wr, int fr) const {
        const int row0 = u.pm * 256 + wr * 64 + fr;
#pragma unroll
        for (int ai = 0; ai < 2; ++ai)
#pragma unroll
            for (int m = 0; m < 4; ++m) { int r = row0 + ai * 128 + m * 16; asm volatile("" : "+v"(r));
                const float a = fx_get(rs2 + r, FX_RS_INV) * (1.0f / 1024.0f) + RMS_EPS, b = fx_get(rs2 + SEQ + r, FX_RS_INV) * (1.0f / 1024.0f) + RMS_EPS;
                const float ratio = __builtin_amdgcn_sqrtf(b * __builtin_amdgcn_rcpf(a));
#pragma unroll
                for (int bj = 0; bj < 2; ++bj)
#pragma unroll
                    for (int n = 0; n < 2; ++n) acc[ai][bj][m][n] *= ratio; }
    }
    template <int ACT> __device__ __forceinline__ void store_bf16(const f32x4 (&acc)[2][2][4][2], const pg8::Unit& u, int wr, int wc, int fr, int fq) const {
        const int row0 = u.pm * 256 + wr * 64 + fr, col0 = u.pn * 256 + wc * 32 + 8 * fq;
#pragma unroll
        for (int ai = 0; ai < 2; ++ai)
#pragma unroll
            for (int m = 0; m < 4; ++m) { bf16_t* rowp = O + (size_t)(row0 + ai * 128 + m * 16) * ldc + col0;
#pragma unroll
                for (int bj = 0; bj < 2; ++bj) { f32x4 v0 = acc[ai][bj][m][0], v1 = acc[ai][bj][m][1];
                    if (ACT == 1) {
#pragma unroll
                        for (int j = 0; j < 4; ++j) { v0[j] = gelu_tanh(v0[j]); v1[j] = gelu_tanh(v1[j]); } }
                    if (ACT == 2) {
#pragma unroll
                        for (int j = 0; j < 4; ++j) { const float a = fmaxf(v0[j], 0.f), b = fmaxf(v1[j], 0.f); v0[j] = a * a; v1[j] = b * b; } }
                    u32x4 w; w.x = cvt_pk_bf16(v0[0], v0[1]); w.y = cvt_pk_bf16(v0[2], v0[3]); w.z = cvt_pk_bf16(v1[0], v1[1]); w.w = cvt_pk_bf16(v1[2], v1[3]);
                    *(GAS u32x4*)(rowp + bj * 128) = w; } }
    }
    template <bool XF32> __device__ __forceinline__ void store_res(const f32x4 (&acc)[2][2][4][2], const pg8::Unit& u, int wr, int wc, int fr, int fq) const {
        const int row0 = u.pm * 256 + wr * 64 + fr, col0 = u.pn * 256 + wc * 32 + 8 * fq;
        f32x4 gv[2][2];
#pragma unroll
        for (int bj = 0; bj < 2; ++bj)
#pragma unroll
            for (int n = 0; n < 2; ++n) gv[bj][n] = *(const GAS f32x4*)(gate + col0 + bj * 128 + n * 4) + 1.0f;
#pragma unroll
        for (int ai = 0; ai < 2; ++ai) {
            float rsc[4];
#pragma unroll
            for (int m = 0; m < 4; ++m) rsc[m] = rs2 ? __builtin_amdgcn_rsqf(fx_get(rs2 + SEQ + row0 + ai * 128 + m * 16, FX_RS_INV) * (1.0f / 1024.0f) + RMS_EPS) : 1.0f;
            u32x4 xpre[4][2];
            if (!XF32) {
#pragma unroll
                for (int m = 0; m < 4; ++m)
#pragma unroll
                    for (int bj = 0; bj < 2; ++bj) xpre[m][bj] = *(const GAS u32x4*)(O + (size_t)(row0 + ai * 128 + m * 16) * DM + col0 + bj * 128); }
#pragma unroll
            for (int m = 0; m < 4; ++m) { const size_t off = (size_t)(row0 + ai * 128 + m * 16) * DM + col0;
#pragma unroll
                for (int bj = 0; bj < 2; ++bj) { f32x4 x0, x1;
                    if (XF32) { x0 = *(const GAS f32x4*)(xin + off + bj * 128); x1 = *(const GAS f32x4*)(xin + off + bj * 128 + 4); }
                    else { const u32x4 xb = xpre[m][bj];
                        x0 = (f32x4){bf2f((unsigned short)(xb.x & 0xffff)), bf2f((unsigned short)(xb.x >> 16)), bf2f((unsigned short)(xb.y & 0xffff)), bf2f((unsigned short)(xb.y >> 16))};
                        x1 = (f32x4){bf2f((unsigned short)(xb.z & 0xffff)), bf2f((unsigned short)(xb.z >> 16)), bf2f((unsigned short)(xb.w & 0xffff)), bf2f((unsigned short)(xb.w >> 16))}; }
                    const f32x4 z0 = ALPHA * x0 + gv[bj][0] * (acc[ai][bj][m][0] * rsc[m]), z1 = ALPHA * x1 + gv[bj][1] * (acc[ai][bj][m][1] * rsc[m]);
                    u32x4 w; w.x = cvt_pk_bf16(z0[0], z0[1]); w.y = cvt_pk_bf16(z0[2], z0[3]); w.z = cvt_pk_bf16(z1[0], z1[1]); w.w = cvt_pk_bf16(z1[2], z1[3]);
                    *(GAS u32x4*)(O + off + bj * 128) = w; }
                if (XF32) asm volatile("" ::: "memory"); } }
    }
    __device__ __forceinline__ void operator()(const f32x4 (&acc)[2][2][4][2], const pg8::Unit& u, int wr, int wc, int fr, int fq) const {
        if (mode == 0) { if (u.pn >= 4) store_bf16<1>(acc, u, wr, wc, fr, fq); else store_bf16<0>(acc, u, wr, wc, fr, fq); }
        else if (mode == 2) store_bf16<2>(acc, u, wr, wc, fr, fq);
        else if (xin) store_res<true>(acc, u, wr, wc, fr, fq);
        else store_res<false>(acc, u, wr, wc, fr, fq);
    }
};

struct Params { const float* in[27]; float* out; unsigned char* ws; };
enum { I_X = 0, I_C, I_ADAW, I_ADAB, I_WIN, I_LRE, I_LIM, I_LDT, I_BRE, I_BIM, I_CRE, I_CIM, I_SD, I_GLUW, I_GLUB, I_SLNG, I_SLNB, I_SGW, I_SGB, I_MNG, I_WOUT, I_LN1G, I_LN1B, I_W1, I_W2, I_LN2G, I_LN2B };

constexpr int MISC_OFF = LDS_BYTES - 1024;
constexpr int PTR_OFF = LDS_BYTES - 512;
constexpr int S5_STRIDE = 17408;
__device__ __forceinline__ const float* inptr(LAS unsigned char* lds, int i) {
    volatile LAS unsigned* q = (volatile LAS unsigned*)(lds + PTR_OFF + 8 * i);
    const unsigned lo = __builtin_amdgcn_readfirstlane(q[0]), hi = __builtin_amdgcn_readfirstlane(q[1]);
    const float* r = (const float*)(((unsigned long long)hi << 32) | lo); ASSUME_GLOBAL(r); return r;
}
struct PtrTab { LAS unsigned char* lds; __device__ __forceinline__ const float* operator[](int i) const { return inptr(lds, i); } };
struct PView { PtrTab in; float* out; unsigned char* ws; };

struct TrItem { const float* W; bf16_t* WT; const float* kscale; int K, N, item; };
__device__ __forceinline__ void tr_load(const TrItem& t, f32x4 (&v)[8], int lane) {
    const int nblk = t.N / 32, kb = t.item / nblk, nb = t.item % nblk, k0 = 64 * kb, n0 = 32 * nb;
#pragma unroll
    for (int i = 0; i < 8; ++i) v[i] = __builtin_nontemporal_load((const GAS f32x4*)(t.W + (size_t)(k0 + 8 * i + (lane >> 3)) * t.N + n0 + 4 * (lane & 7)));
}
__device__ __forceinline__ void tr_finish(const TrItem& t, const f32x4 (&v)[8], LAS float* scr, int lane) {
    const int nblk = t.N / 32, kb = t.item / nblk, nb = t.item % nblk, k0 = 64 * kb, n0 = 32 * nb;
#pragma unroll
    for (int i = 0; i < 8; ++i) { const int kk = 8 * i + (lane >> 3); f32x4 x = v[i]; if (t.kscale) x *= t.kscale[k0 + kk];
        LAS float* d = scr + kk * 33 + 4 * (lane & 7); d[0] = x[0]; d[1] = x[1]; d[2] = x[2]; d[3] = x[3]; }
    LDS_WAIT();
    const int c = lane & 7;
#pragma unroll
    for (int j = 0; j < 4; ++j) { const int n = (lane >> 3) + 8 * j; const LAS float* sp = scr + (8 * c) * 33 + n;
        u32x4 o; o.x = cvt_pk_bf16(sp[0 * 33], sp[1 * 33]); o.y = cvt_pk_bf16(sp[2 * 33], sp[3 * 33]); o.z = cvt_pk_bf16(sp[4 * 33], sp[5 * 33]); o.w = cvt_pk_bf16(sp[6 * 33], sp[7 * 33]);
        *(GAS u32x4*)(t.WT + (size_t)(n0 + n) * t.K + k0 + 8 * c) = o; }
    LDS_WAIT();
}
struct TrPair { const float* W0; bf16_t* T0; const float* s0; int K0, N0, n0; const float* W1; bf16_t* T1; const float* s1; int K1, N1, n1; };
__device__ __forceinline__ TrItem tr_make(const TrPair& p, int it) { TrItem t;
    if (it < p.n0) { t.W = p.W0; t.WT = p.T0; t.kscale = p.s0; t.K = p.K0; t.N = p.N0; t.item = it; }
    else { t.W = p.W1; t.WT = p.T1; t.kscale = p.s1; t.K = p.K1; t.N = p.N1; t.item = it - p.n0; }
    return t; }
__device__ __forceinline__ void tr_run(const TrPair& p, LAS float* scr, int first, int stride, int lane) {
    const int total = p.n0 + p.n1;
    f32x4 vn[8]; TrItem tn;
    if (first < total) { tn = tr_make(p, first); tr_load(tn, vn, lane); }
    for (int it = first; it < total; it += stride) { const TrItem tc = tn; f32x4 vc[8];
#pragma unroll
        for (int i = 0; i < 8; ++i) vc[i] = vn[i];
        if (it + stride < total) { tn = tr_make(p, it + stride); tr_load(tn, vn, lane); }
        tr_finish(tc, vc, scr, lane); }
}
__device__ __forceinline__ void sincos_red(double ang, double& s, double& c) {
    const double TWO_PI = 6.283185307179586476925286766559;
    const double r = ang - TWO_PI * __builtin_rint(ang / TWO_PI);
    const double r2 = r * r; double ts = r, tc = 1.0; s = r; c = 1.0;
#pragma unroll 1
    for (int k = 1; k <= 16; ++k) { tc = -tc * r2 / (double)((2 * k - 1) * (2 * k)); ts = -ts * r2 / (double)((2 * k) * (2 * k + 1)); c += tc; s += ts; }
}
__device__ __forceinline__ double exp_small(double x) {
    double t = 1.0, s = 1.0;
#pragma unroll 1
    for (int k = 1; k <= 14; ++k) { t = t * x / (double)k; s += t; }
    return s;
}

__device__ __forceinline__ void phase_prologue(const PView& p, LAS unsigned char* lds, int tid, int lane, int wave) {
    const float* const in_I_ADAW = p.in[I_ADAW]; const float* const in_I_BIM = p.in[I_BIM]; const float* const in_I_BRE = p.in[I_BRE]; const float* const in_I_C = p.in[I_C]; const float* const in_I_CIM = p.in[I_CIM]; const float* const in_I_CRE = p.in[I_CRE]; const float* const in_I_LDT = p.in[I_LDT]; const float* const in_I_LIM = p.in[I_LIM]; const float* const in_I_LRE = p.in[I_LRE]; const float* const in_I_MNG = p.in[I_MNG]; const float* const in_I_SGW = p.in[I_SGW]; const float* const in_I_W1 = p.in[I_W1]; const float* const in_I_W2 = p.in[I_W2]; const float* const in_I_WIN = p.in[I_WIN]; const float* const in_I_WOUT = p.in[I_WOUT];
    unsigned char* ws = p.ws;
    const int G = gridDim.x, gw = blockIdx.x * NWAVES + wave, NGW = G * NWAVES, gtid = blockIdx.x * NTHREADS + tid, NGT = G * NTHREADS;
    { long long* r2 = (long long*)(ws + WS_RS2); for (int i = gtid; i < DEPTH * 2 * SEQ; i += NGT) r2[i] = 0; }
    { const float* c = in_I_C; const float* aw = in_I_ADAW; float* part = (float*)(ws + WS_MODPART);
      for (int it = gw; it < 2 * 48 * 16; it += NGW) { const int l = it / 768, r = it % 768, nb = r / 16, ks = r % 16;
          const float c0 = c[ks * 128 + lane], c1 = c[ks * 128 + 64 + lane];
          const float s0 = c0 * sigmoidf_(c0), s1 = c1 * sigmoidf_(c1);
          const float* wp = aw + ((size_t)l * DM + ks * 128) * (6 * DM) + nb * 256 + lane * 4;
          f32x4 a = (f32x4){0.f, 0.f, 0.f, 0.f};
#pragma unroll 8
          for (int kk = 0; kk < 64; ++kk) { const float s = __builtin_bit_cast(float, __builtin_amdgcn_readlane(__builtin_bit_cast(int, s0), kk)); a += s * *(const GAS f32x4*)(wp + (size_t)kk * (6 * DM)); }
#pragma unroll 8
          for (int kk = 0; kk < 64; ++kk) { const float s = __builtin_bit_cast(float, __builtin_amdgcn_readlane(__builtin_bit_cast(int, s1), kk)); a += s * *(const GAS f32x4*)(wp + (size_t)(64 + kk) * (6 * DM)); }
          *(GAS f32x4*)(part + ((size_t)ks * 2 + l) * (6 * DM) + nb * 256 + lane * 4) = a; } }
    for (int idx = gtid; idx < DEPTH * NG * NP; idx += NGT) { const int lg = idx / NP, pp = idx % NP;
        const double lr = fmin((double)in_I_LRE[idx], -1e-4), li = (double)in_I_LIM[idx];
        const double dt = (double)__builtin_amdgcn_exp2f(in_I_LDT[lg] * 1.44269504f);
        const double mag = exp_small(lr * dt); double sn, cs; sincos_red(li * dt, sn, cs);
        const double are = mag * cs, aim = mag * sn;
        ((f32x2*)(ws + WS_AB))[idx] = (f32x2){(float)are, (float)aim};
        double ms = mag;
#pragma unroll 1
        for (int k = 0; k < 9; ++k) ms = ms * ms;
        double sn2, cs2; sincos_red(li * dt * (double)SEGLEN, sn2, cs2);
        ((f32x2*)(ws + WS_ABS))[idx] = (f32x2){(float)(ms * cs2), (float)(ms * sn2)};
        const double den = lr * lr + li * li, qre = ((are - 1.0) * lr + aim * li) / den, qim = (aim * lr - (are - 1.0) * li) / den;
        bf16_t* bb = (bf16_t*)(ws + WS_BBF) + ((size_t)lg * 128 + 2 * pp) * 16;
#pragma unroll 1
        for (int h = 0; h < NH; ++h) { const double br = (double)in_I_BRE[(size_t)idx * NH + h], bi = (double)in_I_BIM[(size_t)idx * NH + h];
            bb[h] = f2bf((float)(qre * br - qim * bi)); bb[16 + h] = f2bf((float)(qre * bi + qim * br)); } }
    { bf16_t* cf = (bf16_t*)(ws + WS_CF);
      for (int i = gtid; i < DEPTH * NG * NH * NP; i += NGT) { const int pp = i % NP, rest = i / NP;
          cf[(size_t)rest * 128 + 2 * pp] = f2bf(in_I_CRE[i]); cf[(size_t)rest * 128 + 2 * pp + 1] = f2bf(-in_I_CIM[i]); } }
    { bf16_t* sw = (bf16_t*)(ws + WS_SGUW);
      for (int i = gtid; i < DEPTH * SGH * 128 * 128; i += NGT) { const int s = i & 127, t = (i >> 7) & 127; sw[i] = (s <= t) ? f2bf(in_I_SGW[i]) : (bf16_t)0; } }
    { LAS float* scr = (LAS float*)(lds + wave * 16384);
      constexpr int I_IN = (DM / 64) * (DIN / 32), I_O = (DM / 64) * (DM / 32);
#pragma unroll 1
      for (int l = 0; l < DEPTH; ++l) { TrPair tp;
          tp.W0 = in_I_WIN + (size_t)l * DM * DIN; tp.T0 = (bf16_t*)(ws + WS_WIN) + (size_t)l * DIN * DM; tp.s0 = nullptr; tp.K0 = DM; tp.N0 = DIN; tp.n0 = I_IN;
          tp.W1 = in_I_WOUT + (size_t)l * DM * DM; tp.T1 = (bf16_t*)(ws + WS_WOUT) + (size_t)l * DM * DM; tp.s1 = in_I_MNG + l * DM; tp.K1 = DM; tp.N1 = DM; tp.n1 = I_O;
          tr_run(tp, scr, gw, NGW, lane); } }
}

__device__ __forceinline__ void phase_mod_h0(const PView& p, LAS unsigned char* lds, int tid, int lane, int wave) {
    const float* const in_I_ADAB = p.in[I_ADAB]; const float* const in_I_X = p.in[I_X];
    unsigned char* ws = p.ws;
    const int G = gridDim.x, gw = blockIdx.x * NWAVES + wave, NGW = G * NWAVES, gtid = blockIdx.x * NTHREADS + tid, NGT = G * NTHREADS;
    const float* part = (const float*)(ws + WS_MODPART); const float* ab = in_I_ADAB;
    for (int i = gtid; i < 2 * 6 * DM; i += NGT) { float s = ab[i];
#pragma unroll
        for (int ks = 0; ks < 16; ++ks) s += part[(size_t)ks * (2 * 6 * DM) + i];
        ((float*)(ws + WS_MOD))[i] = s; }
    LAS float* m0 = (LAS float*)lds;
    for (int i = tid; i < 2 * DM; i += NTHREADS) { float s = ab[i];
#pragma unroll
        for (int ks = 0; ks < 16; ++ks) s += part[(size_t)ks * (2 * 6 * DM) + i];
        m0[i] = s; }
    __syncthreads();
    f32x4 sc[8], sh[8];
#pragma unroll
    for (int j = 0; j < 8; ++j) { sh[j] = *(const LAS f32x4*)(m0 + 4 * lane + 256 * j); sc[j] = *(const LAS f32x4*)(m0 + DM + 4 * lane + 256 * j) + 1.0f; }
    const float* x = in_I_X; bf16_t* H = (bf16_t*)(ws + WS_H);
    f32x4 xn[8];
    if (gw < SEQ) {
#pragma unroll
        for (int j = 0; j < 8; ++j) xn[j] = __builtin_nontemporal_load((const GAS f32x4*)(x + (size_t)gw * DM + 4 * lane + 256 * j)); }
    for (int row = gw; row < SEQ; row += NGW) { f32x4 xc[8];
#pragma unroll
        for (int j = 0; j < 8; ++j) xc[j] = xn[j];
        if (row + NGW < SEQ) {
#pragma unroll
            for (int j = 0; j < 8; ++j) xn[j] = __builtin_nontemporal_load((const GAS f32x4*)(x + (size_t)(row + NGW) * DM + 4 * lane + 256 * j)); }
#pragma unroll
        for (int j = 0; j < 8; ++j) { const f32x4 h = xc[j] * sc[j] + sh[j];
            u32x2 w; w.x = cvt_pk_bf16(h[0], h[1]); w.y = cvt_pk_bf16(h[2], h[3]); *(GAS u32x2*)(H + (size_t)row * DM + 4 * lane + 256 * j) = w; } }
    __syncthreads();
}

__device__ __forceinline__ void phase_ln(const bool HAS_H, bf16_t* zx, float* dout, const float* g, const float* b, const float* scale, const float* shift, bf16_t* H, int lane, int wave) {
    const int gw = blockIdx.x * NWAVES + wave, NGW = gridDim.x * NWAVES;
    f32x4 gg[8], bb[8], sc[8], sh[8];
#pragma unroll
    for (int j = 0; j < 8; ++j) { const int c0 = 8 * lane + 512 * (j >> 1) + 4 * (j & 1);
        gg[j] = *(const GAS f32x4*)(g + c0); bb[j] = *(const GAS f32x4*)(b + c0);
        if (HAS_H) { sc[j] = *(const GAS f32x4*)(scale + c0) + 1.0f; sh[j] = *(const GAS f32x4*)(shift + c0); } }
    u32x4 wn[4];
    if (gw < SEQ) {
#pragma unroll
        for (int j = 0; j < 4; ++j) wn[j] = *(const GAS u32x4*)(zx + (size_t)gw * DM + 8 * lane + 512 * j); }
    for (int row = gw; row < SEQ; row += NGW) { bf16_t* zr = zx + (size_t)row * DM + 8 * lane;
        f32x4 v[8]; float s = 0.f;
        u32x4 wc_[4];
#pragma unroll
        for (int j = 0; j < 4; ++j) wc_[j] = wn[j];
        if (row + NGW < SEQ) {
#pragma unroll
            for (int j = 0; j < 4; ++j) wn[j] = *(const GAS u32x4*)(zr + (size_t)NGW * DM + 512 * j); }
#pragma unroll
        for (int j = 0; j < 4; ++j) { const u32x4 w = wc_[j];
            v[2 * j] = (f32x4){bf2f((unsigned short)(w.x & 0xffff)), bf2f((unsigned short)(w.x >> 16)), bf2f((unsigned short)(w.y & 0xffff)), bf2f((unsigned short)(w.y >> 16))};
            v[2 * j + 1] = (f32x4){bf2f((unsigned short)(w.z & 0xffff)), bf2f((unsigned short)(w.z >> 16)), bf2f((unsigned short)(w.w & 0xffff)), bf2f((unsigned short)(w.w >> 16))}; }
#pragma unroll
        for (int j = 0; j < 8; ++j) s += (v[j][0] + v[j][1]) + (v[j][2] + v[j][3]);
        const float mean = wave_sum(s) * (1.0f / DM); float s2 = 0.f;
#pragma unroll
        for (int j = 0; j < 8; ++j) { v[j] = v[j] - mean; s2 += (v[j][0] * v[j][0] + v[j][1] * v[j][1]) + (v[j][2] * v[j][2] + v[j][3] * v[j][3]); }
        const float rstd = 1.0f / sqrtf(wave_sum(s2) * (1.0f / DM) + LN_EPS);
#pragma unroll
        for (int j = 0; j < 4; ++j) { const f32x4 x0 = v[2 * j] * rstd * gg[2 * j] + bb[2 * j], x1 = v[2 * j + 1] * rstd * gg[2 * j + 1] + bb[2 * j + 1];
            if (HAS_H) { u32x4 w; w.x = cvt_pk_bf16(x0[0], x0[1]); w.y = cvt_pk_bf16(x0[2], x0[3]); w.z = cvt_pk_bf16(x1[0], x1[1]); w.w = cvt_pk_bf16(x1[2], x1[3]);
                *(GAS u32x4*)(zr + 512 * j) = w;
                const f32x4 h0 = x0 * sc[2 * j] + sh[2 * j], h1 = x1 * sc[2 * j + 1] + sh[2 * j + 1];
                u32x4 hw; hw.x = cvt_pk_bf16(h0[0], h0[1]); hw.y = cvt_pk_bf16(h0[2], h0[3]); hw.z = cvt_pk_bf16(h1[0], h1[1]); hw.w = cvt_pk_bf16(h1[2], h1[3]);
                *(GAS u32x4*)(H + (size_t)row * DM + 8 * lane + 512 * j) = hw; }
            else { float* orow = dout + (size_t)row * DM + 8 * lane + 512 * j; *(GAS f32x4*)(orow) = x0; *(GAS f32x4*)(orow + 4) = x1; } } }
}

__device__ __forceinline__ void phase_rmsnorm(unsigned char* ws, int l, int lane, int wave) {
    const int gw = blockIdx.x * NWAVES + wave, NGW = gridDim.x * NWAVES;
    bf16_t* Y = (bf16_t*)(ws + WS_Y); const float* rsp = (const float*)(ws + WS_RSP);
    u32x4 vn[4]; float p0n = 0.f, p1n = 0.f;
    if (gw < SEQ) { p0n = *(const GAS float*)(rsp + (size_t)lane * SEQ + gw); p1n = *(const GAS float*)(rsp + (size_t)(NG + (lane & 7)) * SEQ + gw);
#pragma unroll
        for (int j = 0; j < 4; ++j) vn[j] = *(const GAS u32x4*)(Y + (size_t)gw * DM + 8 * lane + 512 * j); }
    for (int row = gw; row < SEQ; row += NGW) {
        const float p0 = p0n, p1 = (lane < SGH) ? p1n : 0.f;
        bf16_t* yr = Y + (size_t)row * DM + 8 * lane;
        u32x4 v[4];
#pragma unroll
        for (int j = 0; j < 4; ++j) v[j] = vn[j];
        if (row + NGW < SEQ) { p0n = *(const GAS float*)(rsp + (size_t)lane * SEQ + row + NGW); p1n = *(const GAS float*)(rsp + (size_t)(NG + (lane & 7)) * SEQ + row + NGW);
#pragma unroll
            for (int j = 0; j < 4; ++j) vn[j] = *(const GAS u32x4*)(yr + (size_t)NGW * DM + 512 * j); }
        const float r0 = __builtin_amdgcn_rsqf(wave_sum(p0) * (1.0f / 1024.0f) + RMS_EPS), r1 = __builtin_amdgcn_rsqf(wave_sum(p1) * (1.0f / 1024.0f) + RMS_EPS);
#pragma unroll
        for (int j = 0; j < 4; ++j) { const float r = (j < 2) ? r0 : r1; u32x4 o;
#pragma unroll
            for (int e = 0; e < 4; ++e) { const unsigned w = v[j][e]; o[e] = cvt_pk_bf16(bf2f((unsigned short)(w & 0xffff)) * r, bf2f((unsigned short)(w >> 16)) * r); }
            *(GAS u32x4*)(yr + 512 * j) = o; } }
}

template <bool PB>
__device__ __forceinline__ void phase_s5(const PView& p, int l, LAS unsigned char* lds, int lane, int wave) {
    const float* const in_I_GLUB = p.in[I_GLUB]; const float* const in_I_GLUW = p.in[I_GLUW]; const float* const in_I_SD = p.in[I_SD];
    unsigned char* ws = p.ws;
    const int gw = blockIdx.x * NWAVES + wave, NGW = gridDim.x * NWAVES;
    const int q = lane >> 4, c = lane & 15;
    LAS unsigned* BuL = (LAS unsigned*)(lds + wave * S5_STRIDE);
    LAS unsigned* HL = (LAS unsigned*)(lds + wave * S5_STRIDE + 4352);
    const bf16_t* PROJ = (const bf16_t*)(ws + WS_PROJ);
    bf16_t* Y = (bf16_t*)(ws + WS_Y);
    long long* rs2 = (long long*)(ws + WS_RS2) + (size_t)(l * 2 + 0) * SEQ;
    f32x2* E = (f32x2*)(ws + WS_E);
    const bf16x8 zero8 = (bf16x8){0, 0, 0, 0, 0, 0, 0, 0};
    const f32x4 zero4 = (f32x4){0.f, 0.f, 0.f, 0.f};
    TrPair tp; const bool conv_first = wave >= 4;
    if (!PB) { const float* const in_I_W1 = p.in[I_W1]; const float* const in_I_W2 = p.in[I_W2];
        tp.W0 = in_I_W1 + (size_t)l * DM * DFF; tp.T0 = (bf16_t*)(ws + WS_W1) + (size_t)l * DFF * DM; tp.s0 = nullptr; tp.K0 = DM; tp.N0 = DFF; tp.n0 = (DM / 64) * (DFF / 32);
        tp.W1 = in_I_W2 + (size_t)l * DFF * DM; tp.T1 = (bf16_t*)(ws + WS_W2) + (size_t)l * DM * DFF; tp.s1 = nullptr; tp.K1 = DFF; tp.N1 = DM; tp.n1 = (DFF / 64) * (DM / 32);
        if (conv_first) tr_run(tp, (LAS float*)(lds + wave * S5_STRIDE + 8704), gw, NGW, lane); }
    for (int item = gw; item < NG * NSEG; item += NGW) {
        const int g = item / NSEG, seg = item % NSEG, lg = l * NG + g;
        bf16x8 bbf[8];
#pragma unroll
        for (int i = 0; i < 8; ++i) bbf[i] = (q < 2) ? *(const GAS bf16x8*)((const bf16_t*)(ws + WS_BBF) + ((size_t)lg * 128 + 16 * i + c) * 16 + 8 * q) : zero8;
        const f32x2 av = ((const f32x2*)(ws + WS_AB))[lg * NP + lane];
        const float ar = av.x, ai = av.y;
        float hr = 0.f, hi = 0.f;
        bf16x8 cfr[4], dfr, glf[2]; float gb0[4], gb1[4];
        if (PB) {
#pragma unroll
            for (int kk = 0; kk < 4; ++kk) cfr[kk] = *(const GAS bf16x8*)((const bf16_t*)(ws + WS_CF) + ((size_t)lg * 16 + c) * 128 + 32 * kk + 8 * q);
            const bf16_t dv = f2bf(in_I_SD[lg * NH + c]);
#pragma unroll
            for (int j = 0; j < 8; ++j) dfr[j] = (q < 2 && 8 * q + j == c) ? (short)dv : (short)0;
#pragma unroll
            for (int t = 0; t < 2; ++t)
#pragma unroll
                for (int j = 0; j < 8; ++j) glf[t][j] = (j < 4) ? (short)f2bf(in_I_GLUW[((size_t)lg * NH + 4 * q + j) * 32 + 16 * t + c]) : (short)0;
#pragma unroll
            for (int r = 0; r < 4; ++r) { gb0[r] = in_I_GLUB[lg * 32 + 4 * q + r]; gb1[r] = in_I_GLUB[lg * 32 + 16 + 4 * q + r]; }
            const f32x2 as = ((const f32x2*)(ws + WS_ABS))[lg * NP + lane];
            f32x2 ev[NSEG - 1];
#pragma unroll
            for (int j = 0; j < NSEG - 1; ++j) ev[j] = (j < seg) ? *(const GAS f32x2*)(E + ((size_t)g * NSEG + j) * NP + lane) : (f32x2){0.f, 0.f};
#pragma unroll
            for (int j = 0; j < NSEG - 1; ++j) if (j < seg) { const float nr = fmaf(as.x, hr, fmaf(-as.y, hi, ev[j].x)), ni = fmaf(as.x, hi, fmaf(as.y, hr, ev[j].y)); hr = nr; hi = ni; }
        }
        const int t0 = seg * SEGLEN;
        const bf16_t* up = PROJ + (size_t)(t0 + c) * DIN + g * 16 + 8 * (q & 1);
        bf16x8 ufA = *(const GAS bf16x8*)up, ufB = *(const GAS bf16x8*)(up + (size_t)16 * DIN);
        asm volatile("" : "+v"(ufA), "+v"(ufB));
        for (int sc = 0; sc < SEGLEN / 16; ++sc) {
            const int pos0 = t0 + 16 * sc;
            const int scn = (sc + 2 < SEGLEN / 16) ? sc + 2 : SEGLEN / 16 - 1;
            const bf16x8 ufC = *(const GAS bf16x8*)(up + (size_t)scn * 16 * DIN);
            const bf16x8 uf = (q < 2) ? ufA : zero8;
#pragma unroll
            for (int i = 0; i < 8; ++i) { const f32x4 d = __builtin_amdgcn_mfma_f32_16x16x32_bf16(bbf[i], uf, zero4, 0, 0, 0);
                u32x2 w; w.x = cvt_pk_bf16(d[0], d[1]); w.y = cvt_pk_bf16(d[2], d[3]); *(LAS u32x2*)(BuL + c * 68 + 8 * i + 2 * q) = w; }
            LDS_WAIT();
            unsigned bu[16];
#pragma unroll
            for (int s = 0; s < 16; ++s) bu[s] = BuL[s * 68 + lane];
#pragma unroll
            for (int s = 0; s < 16; ++s) { const float bx = bf2f((unsigned short)(bu[s] & 0xffff)), by = __builtin_bit_cast(float, bu[s] & 0xffff0000u);
                const float nr = fmaf(ar, hr, fmaf(-ai, hi, bx)), ni = fmaf(ar, hi, fmaf(ai, hr, by)); hr = nr; hi = ni;
                if (PB) HL[s * 68 + lane] = cvt_pk_bf16(hr, hi); }
            LDS_WAIT();
            if (PB) {
                f32x4 y = zero4;
#pragma unroll
                for (int kk = 0; kk < 4; ++kk) { const bf16x8 hf = *(const LAS bf16x8*)((const LAS bf16_t*)HL + c * 136 + 32 * kk + 8 * q); y = __builtin_amdgcn_mfma_f32_16x16x32_bf16(cfr[kk], hf, y, 0, 0, 0); }
                y = __builtin_amdgcn_mfma_f32_16x16x32_bf16(dfr, uf, y, 0, 0, 0);
                bf16x8 gf = zero8;
                { const unsigned w0 = cvt_pk_bf16(gelu_tanh(y[0]), gelu_tanh(y[1])), w1 = cvt_pk_bf16(gelu_tanh(y[2]), gelu_tanh(y[3]));
                  gf[0] = (short)(w0 & 0xffff); gf[1] = (short)(w0 >> 16); gf[2] = (short)(w1 & 0xffff); gf[3] = (short)(w1 >> 16); }
                const f32x4 z0 = __builtin_amdgcn_mfma_f32_16x16x32_bf16(glf[0], gf, zero4, 0, 0, 0);
                const f32x4 z1 = __builtin_amdgcn_mfma_f32_16x16x32_bf16(glf[1], gf, zero4, 0, 0, 0);
                float o[4]; float ss = 0.f;
#pragma unroll
                for (int r = 0; r < 4; ++r) { o[r] = (z0[r] + gb0[r]) * sigmoidf_(z1[r] + gb1[r]); ss += o[r] * o[r]; }
                u32x2 w; w.x = cvt_pk_bf16(o[0], o[1]); w.y = cvt_pk_bf16(o[2], o[3]);
                *(GAS u32x2*)(Y + (size_t)(pos0 + c) * DM + g * 16 + 4 * q) = w;
                ss += __shfl_xor(ss, 16); ss += __shfl_xor(ss, 32);
                if (q == 0) fx_add(rs2 + pos0 + c, ss, FX_RS);
                LDS_WAIT();
            }
            ufA = ufB; ufB = ufC;
        }
        if (!PB) E[((size_t)g * NSEG + seg) * NP + lane] = (f32x2){hr, hi};
    }
    if (!PB && !conv_first) tr_run(tp, (LAS float*)(lds + wave * S5_STRIDE + 8704), gw, NGW, lane);
}

__host__ __device__ constexpr int sgu_wpre(int tt) { int w = 0; for (int i = 0; i < tt; ++i) w += i / 2 + 1; return w; }
__device__ __forceinline__ void phase_sgu(const PView& p, int l, LAS unsigned char* lds, int tid, int lane, int wave) {
    const float* const in_I_SGB = p.in[I_SGB]; const float* const in_I_SLNB = p.in[I_SLNB]; const float* const in_I_SLNG = p.in[I_SLNG];
    unsigned char* ws = p.ws;
    const bf16_t* PROJ = (const bf16_t*)(ws + WS_PROJ);
    bf16_t* Y = (bf16_t*)(ws + WS_Y);
    long long* rs2 = (long long*)(ws + WS_RS2) + (size_t)(l * 2 + 1) * SEQ;
    LAS unsigned* VT = (LAS unsigned*)lds;
    LAS float* RED = (LAS float*)(lds + 36864);
    LAS bf16_t* WL = (LAS bf16_t*)(lds + 40960);
    const int q = lane >> 4, c = lane & 15;
    const int NIT = (SEQ / 128) * SGH, G = gridDim.x;
    const int rp = tid >> 3, ds = tid & 7;
    bf16x8 a0, a1, b0, b1;
    u32x2 uun[8];
    auto prefetch = [&](int item) { const int n = item >> 3, hd = item & 7;
        const bf16_t* vp = PROJ + (size_t)(n * 128 + 2 * rp) * DIN + 2048 + hd * 128 + 16 * ds;
        a0 = *(const GAS bf16x8*)vp; a1 = *(const GAS bf16x8*)(vp + 8); b0 = *(const GAS bf16x8*)(vp + DIN); b1 = *(const GAS bf16x8*)(vp + DIN + 8);
#pragma unroll
        for (int tt = 0; tt < 8; ++tt) uun[tt] = *(const GAS u32x2*)(PROJ + (size_t)(n * 128 + 16 * tt + c) * DIN + 1024 + hd * 128 + 16 * wave + 4 * q); };
    if ((int)blockIdx.x < NIT) prefetch(blockIdx.x);
    int hd_loaded = -1; f32x4 lgv[4], lbv[4]; float bsp[8];
    for (int item = blockIdx.x; item < NIT; item += G) {
        const int n = item >> 3, hd = item & 7;
        if (hd != hd_loaded) {
            if (hd_loaded >= 0) { LDS_WAIT(); __builtin_amdgcn_s_barrier(); }
            const bf16_t* wb = (const bf16_t*)(ws + WS_SGUW) + (size_t)(l * SGH + hd) * 128 * 128;
#pragma unroll
            for (int i = 0; i < 4; ++i) { const int e = tid + NTHREADS * i, t = e >> 4, s8 = e & 15;
                *(LAS bf16x8*)(WL + t * 136 + 8 * s8) = *(const GAS bf16x8*)(wb + (size_t)t * 128 + 8 * s8); }
#pragma unroll
            for (int j4 = 0; j4 < 4; ++j4) { lgv[j4] = *(const GAS f32x4*)(in_I_SLNG + l * 1024 + hd * 128 + 16 * ds + 4 * j4); lbv[j4] = *(const GAS f32x4*)(in_I_SLNB + l * 1024 + hd * 128 + 16 * ds + 4 * j4); }
#pragma unroll
            for (int tt = 0; tt < 8; ++tt) bsp[tt] = *(const GAS float*)(in_I_SGB + (l * SGH + hd) * 128 + 16 * tt + c);
            hd_loaded = hd; }
        u32x2 uu[8];
        { float v0[16], v1[16];
#pragma unroll
          for (int j = 0; j < 8; ++j) { v0[j] = bf2f((unsigned short)a0[j]); v0[8 + j] = bf2f((unsigned short)a1[j]); v1[j] = bf2f((unsigned short)b0[j]); v1[8 + j] = bf2f((unsigned short)b1[j]); }
#pragma unroll
          for (int tt = 0; tt < 8; ++tt) uu[tt] = uun[tt];
          if (item + G < NIT) prefetch(item + G);
          float s0 = 0.f, s1 = 0.f;
#pragma unroll
          for (int j = 0; j < 16; ++j) { s0 += v0[j]; s1 += v1[j]; }
#pragma unroll
          for (int o = 1; o < 8; o <<= 1) { s0 += __shfl_xor(s0, o); s1 += __shfl_xor(s1, o); }
          const float m0 = s0 * (1.0f / 128.0f), m1 = s1 * (1.0f / 128.0f);
          float q0 = 0.f, q1 = 0.f;
#pragma unroll
          for (int j = 0; j < 16; ++j) { v0[j] -= m0; v1[j] -= m1; q0 += v0[j] * v0[j]; q1 += v1[j] * v1[j]; }
#pragma unroll
          for (int o = 1; o < 8; o <<= 1) { q0 += __shfl_xor(q0, o); q1 += __shfl_xor(q1, o); }
          const float r0 = 1.0f / sqrtf(q0 * (1.0f / 128.0f) + LN_EPS), r1 = 1.0f / sqrtf(q1 * (1.0f / 128.0f) + LN_EPS);
#pragma unroll
          for (int j4 = 0; j4 < 4; ++j4)
#pragma unroll
              for (int e = 0; e < 4; ++e) { const int j = 4 * j4 + e; VT[(16 * ds + j) * 68 + rp] = cvt_pk_bf16(v0[j] * r0 * lgv[j4][e] + lbv[j4][e], v1[j] * r1 * lgv[j4][e] + lbv[j4][e]); } }
        LDS_WAIT(); __builtin_amdgcn_s_barrier(); asm volatile("" ::: "memory");
        { bf16x8 af[4];
#pragma unroll
          for (int kk = 0; kk < 4; ++kk) af[kk] = *(const LAS bf16x8*)((const LAS bf16_t*)VT + (16 * wave + c) * 136 + 32 * kk + 8 * q);
#pragma unroll
          for (int tt = 0; tt < 8; ++tt) { f32x4 acc = (f32x4){0.f, 0.f, 0.f, 0.f};
#pragma unroll
              for (int kk = 0; kk < 4; ++kk) if (kk <= tt / 2) { const bf16x8 wf = *(const LAS bf16x8*)(WL + (16 * tt + c) * 136 + 32 * kk + 8 * q); acc = __builtin_amdgcn_mfma_f32_16x16x32_bf16(af[kk], wf, acc, 0, 0, 0); }
              const int t = n * 128 + 16 * tt + c;
              float o[4];
              o[0] = bf2f((unsigned short)(uu[tt].x & 0xffff)) * (acc[0] + bsp[tt]); o[1] = bf2f((unsigned short)(uu[tt].x >> 16)) * (acc[1] + bsp[tt]);
              o[2] = bf2f((unsigned short)(uu[tt].y & 0xffff)) * (acc[2] + bsp[tt]); o[3] = bf2f((unsigned short)(uu[tt].y >> 16)) * (acc[3] + bsp[tt]);
              u32x2 wv; wv.x = cvt_pk_bf16(o[0], o[1]); wv.y = cvt_pk_bf16(o[2], o[3]);
              *(GAS u32x2*)(Y + (size_t)t * DM + 1024 + hd * 128 + 16 * wave + 4 * q) = wv;
              float ss = (o[0] * o[0] + o[1] * o[1]) + (o[2] * o[2] + o[3] * o[3]);
              ss += __shfl_xor(ss, 16); ss += __shfl_xor(ss, 32);
              if (q == 0) RED[wave * 128 + 16 * tt + c] = ss; } }
        LDS_WAIT(); __builtin_amdgcn_s_barrier(); asm volatile("" ::: "memory");
        if (tid < 128) { float a = 0.f;
#pragma unroll
            for (int w = 0; w < 8; ++w) a += RED[w * 128 + tid];
            fx_add(rs2 + n * 128 + tid, a, FX_RS); }
    }
}

#define GSYNC() do { __builtin_amdgcn_fence(__ATOMIC_RELEASE, "agent"); asm volatile("s_waitcnt vmcnt(0) lgkmcnt(0)" ::: "memory"); grid.sync(); \
    __builtin_amdgcn_fence(__ATOMIC_ACQUIRE, "agent"); asm volatile("s_waitcnt vmcnt(0)" ::: "memory"); __syncthreads(); } while (0)
__global__ void __launch_bounds__(NTHREADS, 2) mk_fwd(Params p) {
    extern __shared__ __attribute__((aligned(16))) unsigned char lds_raw[];
    LAS unsigned char* lds0 = (LAS unsigned char*)lds_raw;
    cg::grid_group grid = cg::this_grid();
    if (threadIdx.x < 27) *(LAS unsigned long long*)(lds0 + PTR_OFF + 8 * threadIdx.x) = (unsigned long long)p.in[threadIdx.x];
    if (threadIdx.x < 2) ((LAS unsigned*)(lds0 + MISC_OFF))[threadIdx.x] = 0u;
    __syncthreads();
    const XcdBarrier xbar = xcd_barrier_post((unsigned*)(p.ws + WS_BAR), (volatile LAS unsigned*)(lds0 + MISC_OFF));
    const int G = gridDim.x;
    { const int tid = threadIdx.x, lane = tid & 63, wave = __builtin_amdgcn_readfirstlane(tid >> 6);
      PView pv; pv.in.lds = lds0; pv.out = p.out; pv.ws = p.ws;
#ifndef SK_P0
      phase_prologue(pv, lds0, tid, lane, wave);
#endif
      if (p.ws == nullptr) grid.sync();
      xcd_barrier(xbar);
#ifndef SK_P0C
      phase_mod_h0(pv, lds0, tid, lane, wave);
#endif
      xcd_barrier(xbar); }

    constexpr int NSTEP = 8;
#pragma unroll 1
    for (int step = 0; step < DEPTH * NSTEP; ++step) {
        const int l = step / NSTEP, k = step % NSTEP;
        unsigned char* ws = p.ws; float* out = p.out; int tid = threadIdx.x; LAS unsigned char* lds = lds0;
        asm volatile("" : "+s"(ws), "+s"(out), "+v"(tid), "+s"(lds));
        ASSUME_GLOBAL(ws); ASSUME_GLOBAL(out);
        const int lane = tid & 63, wave = __builtin_amdgcn_readfirstlane(tid >> 6);
        PView pv; pv.in.lds = lds; pv.out = out; pv.ws = ws;
        const float* MOD = (const float*)(ws + WS_MOD);
        bf16_t* H = (bf16_t*)(ws + WS_H);
        const float* mod = MOD + (size_t)l * 6 * DM;
        if (k == 0 || k == 3 || k == 5 || k == 6) {
            pg8::Gemm g; EpiAll E; E.O = nullptr; E.ldc = 0; E.xin = nullptr; E.gate = nullptr; E.rs2 = nullptr;
            if (k == 0) {
                g = pg8::Gemm{H, (const bf16_t*)(ws + WS_WIN) + (size_t)l * DIN * DM, SEQ, DIN, DM};
                E.mode = 0; E.O = (bf16_t*)(ws + WS_PROJ); E.ldc = DIN;
            } else if (k == 3) {
                g = pg8::Gemm{(const bf16_t*)(ws + WS_Y), (const bf16_t*)(ws + WS_WOUT) + (size_t)l * DM * DM, SEQ, DM, DM};
                E.mode = 1; E.O = (bf16_t*)(ws + WS_ZX); E.ldc = DM; if (l == 0) E.xin = pv.in[I_X]; E.gate = mod + 2 * DM; E.rs2 = (const long long*)(ws + WS_RS2) + (size_t)l * 2 * SEQ;
            } else if (k == 5) {
                g = pg8::Gemm{H, (const bf16_t*)(ws + WS_W1) + (size_t)l * DFF * DM, SEQ, DFF, DM};
                E.mode = 2; E.O = (bf16_t*)(ws + WS_BIG); E.ldc = DFF;
            } else {
                g = pg8::Gemm{(const bf16_t*)(ws + WS_BIG), (const bf16_t*)(ws + WS_W2) + (size_t)l * DM * DFF, SEQ, DM, DFF};
                E.mode = 1; E.O = (bf16_t*)(ws + WS_ZX); E.ldc = DM; E.gate = mod + 5 * DM;
            }
            pg8::StaticOrder S; S.init(g.M, g.N, G, (int)blockIdx.x, k == 6 ? 1 : 0);
#ifndef SK_G
            pg8::gemm_phase<EpiAll, pg8::StaticOrder>(lds, g, S, E, tid);
#endif
        } else if (k == 1) {
#ifndef SK_S5A
            phase_s5<false>(pv, l, lds, lane, wave);
#endif
            __syncthreads();
#ifndef SK_SGU
            phase_sgu(pv, l, lds, tid, lane, wave);
#endif
        } else if (k == 2) {
#ifndef SK_S5B
            phase_s5<true>(pv, l, lds, lane, wave);
#endif
        } else {
#ifndef SK_LN
            const bool has_h = (k == 4) || (l + 1 < DEPTH);
            const float* modn = MOD + (size_t)(l + 1) * 6 * DM;
            const float* gp = pv.in[k == 4 ? I_LN1G : I_LN2G] + l * DM; const float* bp = pv.in[k == 4 ? I_LN1B : I_LN2B] + l * DM;
            phase_ln(has_h, (bf16_t*)(ws + WS_ZX), out, gp, bp, k == 4 ? mod + 4 * DM : modn + 1 * DM, k == 4 ? mod + 3 * DM : modn, H, lane, wave);
#endif
        }
        if (step + 1 < DEPTH * NSTEP) { XcdBarrier xb; xb.bar = (unsigned*)(ws + WS_BAR); xb.x = xb_xcc_id(); xb.st = (volatile LAS unsigned*)(lds + MISC_OFF); xcd_barrier(xb); }
    }
}

extern "C" void kernel_launch(void* const* d_in, const int* in_sizes, int n_in, void* d_out, int out_size, void* d_ws, size_t ws_size, hipStream_t stream) {
    static int grid = 0;
    if (grid == 0) {
        if (n_in != 27 || out_size != SEQ * DM || ws_size < WS_END) { fprintf(stderr, "kernel_launch: unexpected shapes (n_in %d, out %d, ws %zu)\n", n_in, out_size, ws_size); grid = -1; return; }
        int dev = 0, cus = 0, per_cu = 0;
(void)hipGetDevice(&dev);
        (void)hipDeviceGetAttribute(&cus, hipDeviceAttributeMultiprocessorCount, dev);
        if (hipFuncSetAttribute((const void*)mk_fwd, hipFuncAttributeMaxDynamicSharedMemorySize, LDS_BYTES) != hipSuccess) { fprintf(stderr, "kernel_launch: hipFuncSetAttribute failed\n"); grid = -1; return; }
        if (hipOccupancyMaxActiveBlocksPerMultiprocessor(&per_cu, (const void*)mk_fwd, NTHREADS, LDS_BYTES) != hipSuccess || per_cu < 1) { fprintf(stderr, "kernel_launch: occupancy query says %d\n", per_cu); per_cu = 1; }
        (void)hipGetLastError();
        grid = cus * per_cu;
        if (grid > 256) grid = 256;
    }
    if (grid < 0) return;
    Params p{};
    for (int i = 0; i < 27; ++i) p.in[i] = (const float*)d_in[i];
    p.out = (float*)d_out; p.ws = (unsigned char*)d_ws;
    if (hipMemsetAsync((char*)d_ws + WS_BAR, 0, XCD_BAR_WORDS * 4, stream) != hipSuccess) { fprintf(stderr, "kernel_launch: memset failed\n"); return; }
    void* args[] = {&p};
    hipError_t e = hipLaunchCooperativeKernel((const void*)mk_fwd, dim3(grid), dim3(NTHREADS), args, LDS_BYTES, stream);
    if (e != hipSuccess) fprintf(stderr, "cooperative launch failed: %s (grid %d)\n", hipGetErrorString(e), grid);
}
```
